# Optimizing an MI355X kernel written in HIP

```python
import jax, jax.numpy as jnp
from jax import lax
import numpy as np

D_MODEL = 4096
BATCH = 2
SEQ = 8192
DEPTH = 2

HEAD_DIM = 128
N_GROUPS = 4
N_GROUP_HEADS = D_MODEL // HEAD_DIM // N_GROUPS
GROUP_WIDTH = N_GROUP_HEADS * HEAD_DIM
MIX_WIDTH = N_GROUPS * GROUP_WIDTH
RET_HEADS = N_GROUP_HEADS
RET_CHUNK = 128
MLA_HEADS = N_GROUP_HEADS
MLA_Q_LORA = GROUP_WIDTH
MLA_KV_LORA = 512
MLA_NOPE = 128
MLA_ROPE = 64
MLA_V = 128
FOX_HEADS = N_GROUP_HEADS
Q_BLOCK = 128
CONV_CH = GROUP_WIDTH
CONV_K = 31
D_FF = 11008
PLE_DIM = 256
ROPE_THETA = 10000.0
NORM_EPS = 1e-6
LN_EPS = 1e-5

SPLIT_SIZES = (GROUP_WIDTH, GROUP_WIDTH, GROUP_WIDTH, GROUP_WIDTH,
               MLA_Q_LORA, MLA_KV_LORA, MLA_ROPE,
               GROUP_WIDTH, GROUP_WIDTH, GROUP_WIDTH, FOX_HEADS,
               2 * CONV_CH)
SPLIT_POINTS = tuple(int(v) for v in np.cumsum(SPLIT_SIZES)[:-1])
N_IN = sum(SPLIT_SIZES)

kernel_name = "hybrid_parallel_ret_mla_fox_conv_macaron"

F32 = jnp.float32


def rms_norm(x, g):
    xf = x.astype(F32)
    y = xf * lax.rsqrt(jnp.mean(xf * xf, axis=-1, keepdims=True) + NORM_EPS)
    return (y * g.astype(F32)).astype(x.dtype)


def layer_norm(x, g, b):
    xf = x.astype(F32)
    mu = jnp.mean(xf, axis=-1, keepdims=True)
    var = jnp.mean(jnp.square(xf - mu), axis=-1, keepdims=True)
    y = (xf - mu) * lax.rsqrt(var + LN_EPS)
    return (y * g.astype(F32) + b.astype(F32)).astype(x.dtype)


def swiglu(x, w_gate, w_up, w_down):
    return (jax.nn.silu(x @ w_gate) * (x @ w_up)) @ w_down


def rope(x, positions):
    half = x.shape[-1] // 2
    inv_freq = ROPE_THETA ** (-jnp.arange(half, dtype=F32) / half)
    ang = positions.astype(F32)[..., None] * inv_freq
    cos = jnp.cos(ang)[:, :, None, :]
    sin = jnp.sin(ang)[:, :, None, :]
    x1 = x[..., :half].astype(F32)
    x2 = x[..., half:].astype(F32)
    out = jnp.concatenate([x1 * cos - x2 * sin, x2 * cos + x1 * sin], axis=-1)
    return out.astype(x.dtype)


def retention(q, k, v):
    B, H, S, d = q.shape
    n_chunks = S // RET_CHUNK
    log_gamma = jnp.log(1.0 - 2.0 ** (-5.0 - jnp.arange(H, dtype=F32)))
    idx = jnp.arange(RET_CHUNK, dtype=F32)
    lg = log_gamma[:, None]
    diff = idx[:, None] - idx[None, :]
    intra = jnp.where(diff >= 0, jnp.exp(lg[:, :, None] * jnp.maximum(diff, 0.0)), 0.0)
    q_dec = jnp.exp(lg * (idx + 1.0))[None, :, :, None]
    k_dec = jnp.exp(lg * (RET_CHUNK - 1.0 - idx))[None, :, :, None]
    chunk_dec = jnp.exp(log_gamma * RET_CHUNK)[None, :, None, None]

    def to_chunks(t):
        return t.astype(F32).reshape(B, H, n_chunks, RET_CHUNK, t.shape[-1]).transpose(2, 0, 1, 3, 4)

    def step(state, qkv):
        qc, kc, vc = qkv
        scores = jnp.einsum('bhid,bhjd->bhij', qc, kc) * intra
        inner = jnp.einsum('bhij,bhjd->bhid', scores, vc)
        cross = jnp.einsum('bhid,bhde->bhie', qc * q_dec, state)
        new_state = state * chunk_dec + jnp.einsum('bhjd,bhje->bhde', kc * k_dec, vc)
        return new_state, inner + cross

    state0 = jnp.zeros((B, H, d, v.shape[-1]), F32)
    _, out = lax.scan(step, state0, (to_chunks(q), to_chunks(k), to_chunks(v)))
    return out.transpose(1, 2, 0, 3, 4).reshape(B, H, S, v.shape[-1])


def causal_block_attention(q, k, v, scale, cum=None):
    B, H, S, dk = q.shape
    nb = S // Q_BLOCK
    q_blocks = q.reshape(B, H, nb, Q_BLOCK, dk).transpose(2, 0, 1, 3, 4)
    k_pos = jnp.arange(S)

    def one_block(i, q_blk, c_blk):
        s = jnp.einsum('bhqd,bhkd->bhqk', q_blk, k, preferred_element_type=F32) * scale
        if c_blk is not None:
            s = s + (c_blk[..., :, None] - cum[:, :, None, :])
        q_pos = i * Q_BLOCK + jnp.arange(Q_BLOCK)
        s = jnp.where(k_pos[None, :] <= q_pos[:, None], s, -jnp.inf)
        prob = jax.nn.softmax(s, axis=-1)
        return jnp.einsum('bhqk,bhkd->bhqd', prob.astype(v.dtype), v)

    if cum is None:
        out = lax.map(lambda a: one_block(a[0], a[1], None), (jnp.arange(nb), q_blocks))
    else:
        c_blocks = cum.reshape(B, H, nb, Q_BLOCK).transpose(2, 0, 1, 3)
        out = lax.map(lambda a: one_block(a[0], a[1], a[2]), (jnp.arange(nb), q_blocks, c_blocks))
    return out.transpose(1, 2, 0, 3, 4).reshape(B, H, S, v.shape[-1])


def token_mix(hn, positions, w_in, mla_q_norm, mla_w_uq, mla_kv_norm, mla_w_ukv,
              ret_gn_gain, ret_gn_bias, fox_forget_bias, conv_glu_bias, conv_dw, conv_dw_bias,
              conv_ln_gain, conv_ln_bias, conv_w_pw, conv_pw_bias, w_out):
    B, S, _ = hn.shape
    proj = hn @ w_in
    (r_q, r_k, r_v, r_g, m_cq, m_ckv, m_kr,
     f_q, f_k, f_v, f_f, c_in) = jnp.split(proj, SPLIT_POINTS, axis=-1)

    def heads(t, h):
        return t.reshape(B, S, h, -1)

    def to_bhsd(t):
        return t.transpose(0, 2, 1, 3)

    def merge(t):
        return t.transpose(0, 2, 1, 3).reshape(B, S, -1)

    rq = to_bhsd(rope(heads(r_q, RET_HEADS), positions))
    rk = to_bhsd(rope(heads(r_k, RET_HEADS), positions)) * HEAD_DIM ** -0.5
    rv = to_bhsd(heads(r_v, RET_HEADS))
    ro = retention(rq, rk, rv)
    mu = jnp.mean(ro, axis=-1, keepdims=True)
    var = jnp.mean(jnp.square(ro - mu), axis=-1, keepdims=True)
    ro = merge((ro - mu) * lax.rsqrt(var + LN_EPS))
    ro = (ro * ret_gn_gain.astype(F32) + ret_gn_bias.astype(F32)) * jax.nn.silu(r_g.astype(F32))
    y_ret = ro.astype(hn.dtype)

    mq = heads(rms_norm(m_cq, mla_q_norm) @ mla_w_uq, MLA_HEADS)
    mq = jnp.concatenate([mq[..., :MLA_NOPE], rope(mq[..., MLA_NOPE:], positions)], axis=-1)
    kv = heads(rms_norm(m_ckv, mla_kv_norm) @ mla_w_ukv, MLA_HEADS)
    k_rope = jnp.broadcast_to(rope(m_kr[:, :, None, :], positions), (B, S, MLA_HEADS, MLA_ROPE))
    mk = jnp.concatenate([kv[..., :MLA_NOPE], k_rope], axis=-1)
    mv = kv[..., MLA_NOPE:]
    y_mla = merge(causal_block_attention(to_bhsd(mq), to_bhsd(mk), to_bhsd(mv),
                                         (MLA_NOPE + MLA_ROPE) ** -0.5))

    log_f = jax.nn.log_sigmoid(f_f.astype(F32) + fox_forget_bias.astype(F32))
    cum = jnp.cumsum(log_f, axis=1).transpose(0, 2, 1)
    y_fox = merge(causal_block_attention(to_bhsd(heads(f_q, FOX_HEADS)), to_bhsd(heads(f_k, FOX_HEADS)),
                                         to_bhsd(heads(f_v, FOX_HEADS)), HEAD_DIM ** -0.5, cum))

    c_in = c_in + conv_glu_bias
    u = c_in[..., :CONV_CH] * jax.nn.sigmoid(c_in[..., CONV_CH:])
    y = lax.conv_general_dilated(u, conv_dw[:, None, :].astype(u.dtype), window_strides=(1,),
                                 padding=[(CONV_K - 1, 0)],
                                 dimension_numbers=('NWC', 'WIO', 'NWC'),
                                 feature_group_count=CONV_CH) + conv_dw_bias
    y = jax.nn.silu(layer_norm(y, conv_ln_gain, conv_ln_bias))
    y_conv = y @ conv_w_pw + conv_pw_bias

    return jnp.concatenate([y_ret, y_mla, y_fox, y_conv], axis=-1) @ w_out


def setup_inputs(seed: int = 0) -> dict:
    key = jax.random.key(seed)
    ks = iter(jax.random.split(key, 48))

    def w(shape, fan_in):
        return jax.random.normal(next(ks), (DEPTH,) + shape, F32) * fan_in ** -0.5

    def gain(n):
        return 1.0 + 0.02 * jax.random.normal(next(ks), (DEPTH, n), F32)

    def bias(n):
        return 0.02 * jax.random.normal(next(ks), (DEPTH, n), F32)

    x = jax.random.normal(next(ks), (BATCH, SEQ, D_MODEL), F32)
    p = jax.random.normal(next(ks), (DEPTH, BATCH, SEQ, PLE_DIM), F32)
    offset = jax.random.randint(next(ks), (BATCH, 1), 0, 4096, dtype=jnp.int32)
    positions = offset + jnp.arange(SEQ, dtype=jnp.int32)[None, :]
    return {
        "x": x,
        "p": p,
        "positions": positions,
        "ffn1_norm_pre": gain(D_MODEL),
        "ffn1_w_gate": w((D_MODEL, D_FF), D_MODEL),
        "ffn1_w_up": w((D_MODEL, D_FF), D_MODEL),
        "ffn1_w_down": w((D_FF, D_MODEL), D_FF),
        "ffn1_norm_post": gain(D_MODEL),
        "mix_norm_pre": gain(D_MODEL),
        "w_in": w((D_MODEL, N_IN), D_MODEL),
        "mla_q_norm": gain(MLA_Q_LORA),
        "mla_w_uq": w((MLA_Q_LORA, MLA_HEADS * (MLA_NOPE + MLA_ROPE)), MLA_Q_LORA),
        "mla_kv_norm": gain(MLA_KV_LORA),
        "mla_w_ukv": w((MLA_KV_LORA, MLA_HEADS * (MLA_NOPE + MLA_V)), MLA_KV_LORA),
        "ret_gn_gain": gain(GROUP_WIDTH),
        "ret_gn_bias": bias(GROUP_WIDTH),
        "fox_forget_bias": bias(FOX_HEADS),
        "conv_glu_bias": bias(2 * CONV_CH),
        "conv_dw": w((CONV_K, CONV_CH), CONV_K),
        "conv_dw_bias": bias(CONV_CH),
        "conv_ln_gain": gain(CONV_CH),
        "conv_ln_bias": bias(CONV_CH),
        "conv_w_pw": w((CONV_CH, CONV_CH), CONV_CH),
        "conv_pw_bias": bias(CONV_CH),
        "w_out": w((MIX_WIDTH, D_MODEL), MIX_WIDTH),
        "mix_norm_post": gain(D_MODEL),
        "ffn2_norm_pre": gain(D_MODEL),
        "ffn2_w_gate": w((D_MODEL, D_FF), D_MODEL),
        "ffn2_w_up": w((D_MODEL, D_FF), D_MODEL),
        "ffn2_w_down": w((D_FF, D_MODEL), D_FF),
        "ffn2_norm_post": gain(D_MODEL),
        "ple_norm_in": gain(D_MODEL),
        "ple_w_gate": w((D_MODEL, D_MODEL), D_MODEL),
        "ple_w_proj": w((PLE_DIM, D_MODEL), PLE_DIM),
        "ple_norm_post": gain(D_MODEL),
    }


def reference(x, p, positions,
              ffn1_norm_pre, ffn1_w_gate, ffn1_w_up, ffn1_w_down, ffn1_norm_post,
              mix_norm_pre, w_in, mla_q_norm, mla_w_uq, mla_kv_norm, mla_w_ukv,
              ret_gn_gain, ret_gn_bias, fox_forget_bias, conv_glu_bias, conv_dw, conv_dw_bias,
              conv_ln_gain, conv_ln_bias, conv_w_pw, conv_pw_bias, w_out, mix_norm_post,
              ffn2_norm_pre, ffn2_w_gate, ffn2_w_up, ffn2_w_down, ffn2_norm_post,
              ple_norm_in, ple_w_gate, ple_w_proj, ple_norm_post):
    h = x
    for i in range(DEPTH):
        hn = rms_norm(h, ffn1_norm_pre[i])
        h = h + 0.5 * rms_norm(swiglu(hn, ffn1_w_gate[i], ffn1_w_up[i], ffn1_w_down[i]), ffn1_norm_post[i])
        hn = rms_norm(h, mix_norm_pre[i])
        mixed = token_mix(hn, positions, w_in[i], mla_q_norm[i], mla_w_uq[i], mla_kv_norm[i], mla_w_ukv[i],
                          ret_gn_gain[i], ret_gn_bias[i], fox_forget_bias[i], conv_glu_bias[i], conv_dw[i],
                          conv_dw_bias[i], conv_ln_gain[i], conv_ln_bias[i], conv_w_pw[i], conv_pw_bias[i],
                          w_out[i])
        h = h + rms_norm(mixed, mix_norm_post[i])
        hn = rms_norm(h, ffn2_norm_pre[i])
        h = h + 0.5 * rms_norm(swiglu(hn, ffn2_w_gate[i], ffn2_w_up[i], ffn2_w_down[i]), ffn2_norm_post[i])
        gate = jax.nn.sigmoid(rms_norm(h, ple_norm_in[i]) @ ple_w_gate[i])
        h = h + rms_norm(gate * (p[i] @ ple_w_proj[i]), ple_norm_post[i])
    return h
```

```cpp
#include <hip/hip_runtime.h>
#include <cstdio>
#include <cstdint>
#include <cstring>
#include <cmath>
namespace pg8 {
#define PG8_LAS __attribute__((address_space(3)))
typedef unsigned short bf16_t;
typedef short bf16x8 __attribute__((ext_vector_type(8)));
typedef float f32x4 __attribute__((ext_vector_type(4)));
typedef unsigned u32x4 __attribute__((ext_vector_type(4)));
constexpr int BM = 256, BK = 64, HALF = 128, HTB = HALF * BK * 2  , STAGE_BYTES = 8 * HTB, NXCD = 8, WGM = 8;

__host__ __device__ __forceinline__ int lds_byte(int r, int c) { const int st = (r >> 4) * 2 + (c >> 5), rr = r & 15, cc = c & 31, ob = rr * 64 + cc * 2; return st * 1024 + (ob ^ (((ob >> 9) & 1) << 5)); }
__host__ __device__ __forceinline__ void stage_rc(int b, int& R, int& C) { const int st = b / 1024, sb = b % 1024, swz = sb ^ (((sb >> 9) & 1) << 5); R = (st >> 1) * 16 + swz / 64; C = (st & 1) * 32 + (swz % 64) / 2; }
__host__ __device__ __forceinline__ int perm32(int rho) { const int n = rho >> 4, i = rho & 15; return 8 * (i >> 2) + 4 * n + (i & 3); }

struct Unit { int pm, pn; };
struct Gemm { const bf16_t* A; const bf16_t* Bt; int M, N, K; };

struct StaticOrder {
    int nM, nN, nwg, G, c, wgm;
    __host__ __device__ void init(int M, int N, int G_, int c_, int wgm_ = 4) { nM = M / BM; nN = N / BM; nwg = nM * nN; G = G_; c = c_; wgm = wgm_; }
    __host__ __device__ bool next(int i, Unit& u) const {
        const long L = (long)i * G + c; if (L >= nwg) return false;
        int wgid = (int)L; { const int q = nwg / NXCD, r = nwg % NXCD, xcd = wgid % NXCD, off = wgid / NXCD; wgid = (xcd < r ? xcd * (q + 1) : r * (q + 1) + (xcd - r) * q) + off; }
        const int nig = wgm * nN, gid = wgid / nig, fm = gid * wgm, gsz = (nM - fm) < wgm ? (nM - fm) : wgm;
        u.pm = fm + ((wgid % nig) % gsz); u.pn = (wgid % nig) / gsz; return true;
    }
    __device__ __forceinline__ void a_ready(const Unit&) const {}
    __device__ __forceinline__ void done(const Unit&) const {}
};

__device__ __forceinline__ unsigned cvt_pk_bf16(float lo, float hi) { unsigned r; asm volatile("v_cvt_pk_bf16_f32 %0, %1, %2" : "=v"(r) : "v"(lo), "v"(hi)); return r; }
__device__ __forceinline__ float sigm(float x) { return __builtin_amdgcn_rcpf(1.0f + __builtin_amdgcn_exp2f(-1.4426950408889634f * x)); }
typedef unsigned u32x2 __attribute__((ext_vector_type(2)));
#define PG8_GAS __attribute__((address_space(1)))

struct EpiF32 {
    static constexpr bool PERM = false, AFTER_DRAIN = false;
    float* C; int ldc;
    __device__ __forceinline__ void pre(const Unit&, int, int, float (&)[8]) const {}
    __device__ __forceinline__ void operator()(const f32x4 (&acc)[2][2][4][2], const Unit& u, int wr, int wc, int fr, int fq, const float (&)[8]) const {
        const int row0 = u.pm * BM + wr * 64 + fr, col0 = u.pn * BM + wc * 32 + 4 * fq;
#pragma unroll
        for (int ai = 0; ai < 2; ++ai)
#pragma unroll
            for (int m = 0; m < 4; ++m) { float* rowp = C + (size_t)(row0 + ai * HALF + m * 16) * ldc + col0;
#pragma unroll
                for (int bj = 0; bj < 2; ++bj)
#pragma unroll
                    for (int n = 0; n < 2; ++n) *(PG8_GAS f32x4*)(rowp + bj * HALF + n * 16) = acc[ai][bj][m][n]; }
    }
};
struct EpiBf16P {
    static constexpr bool PERM = true, AFTER_DRAIN = false;
    bf16_t* O; int ldc; const float* bias; const float* rsc;
    __device__ __forceinline__ void pre(const Unit& u, int wr, int fr, float (&rsp)[8]) const { const int row0 = u.pm * BM + wr * 64 + fr;
#pragma unroll
        for (int i = 0; i < 8; ++i) rsp[i] = rsc ? ((const PG8_GAS float*)rsc)[row0 + (i >> 2) * HALF + (i & 3) * 16] : 1.0f; }
    __device__ __forceinline__ void operator()(const f32x4 (&acc)[2][2][4][2], const Unit& u, int wr, int wc, int fr, int fq, const float (&rsp)[8]) const {
        const int row0 = u.pm * BM + wr * 64 + fr; const int col0 = u.pn * BM + wc * 32 + 8 * fq;
        float rs[2][4];
#pragma unroll
        for (int ai = 0; ai < 2; ++ai)
#pragma unroll
            for (int m = 0; m < 4; ++m) rs[ai][m] = rsp[ai * 4 + m];
        f32x4 bv[2][2];
#pragma unroll
        for (int bj = 0; bj < 2; ++bj)
#pragma unroll
            for (int n = 0; n < 2; ++n) bv[bj][n] = bias ? *(const PG8_GAS f32x4*)(bias + col0 + bj * HALF + 4 * n) : (f32x4){0.f, 0.f, 0.f, 0.f};
#pragma unroll
        for (int ai = 0; ai < 2; ++ai)
#pragma unroll
            for (int m = 0; m < 4; ++m) { bf16_t* rowp = O + (size_t)(row0 + ai * HALF + m * 16) * ldc + col0;
#pragma unroll
                for (int bj = 0; bj < 2; ++bj) { const f32x4 v0 = acc[ai][bj][m][0] * rs[ai][m] + bv[bj][0], v1 = acc[ai][bj][m][1] * rs[ai][m] + bv[bj][1];
                    u32x4 w; w.x = cvt_pk_bf16(v0[0], v0[1]); w.y = cvt_pk_bf16(v0[2], v0[3]); w.z = cvt_pk_bf16(v1[0], v1[1]); w.w = cvt_pk_bf16(v1[2], v1[3]);
                    __builtin_nontemporal_store(w, (PG8_GAS u32x4*)(rowp + bj * HALF)); } }
    }
};
struct EpiSwiglu {
    static constexpr bool PERM = true, AFTER_DRAIN = false;
    bf16_t* O; int ldc; const float* rsc;
    __device__ __forceinline__ void pre(const Unit& u, int wr, int fr, float (&rsp)[8]) const { const int row0 = u.pm * BM + wr * 64 + fr;
#pragma unroll
        for (int i = 0; i < 8; ++i) rsp[i] = rsc ? ((const PG8_GAS float*)rsc)[row0 + (i >> 2) * HALF + (i & 3) * 16] : 1.0f; }
    __device__ __forceinline__ void operator()(const f32x4 (&acc)[2][2][4][2], const Unit& u, int wr, int wc, int fr, int fq, const float (&rsp)[8]) const {
        const int row0 = u.pm * BM + wr * 64 + fr; const int col0 = u.pn * HALF + wc * 32 + 8 * fq;
        float rs[2][4];
#pragma unroll
        for (int ai = 0; ai < 2; ++ai)
#pragma unroll
            for (int m = 0; m < 4; ++m) rs[ai][m] = rsp[ai * 4 + m];
#pragma unroll
        for (int ai = 0; ai < 2; ++ai)
#pragma unroll
            for (int m = 0; m < 4; ++m) { bf16_t* rowp = O + (size_t)(row0 + ai * HALF + m * 16) * ldc + col0;
                float v[8];
#pragma unroll
                for (int n = 0; n < 2; ++n)
#pragma unroll
                    for (int j = 0; j < 4; ++j) { const float g = acc[ai][0][m][n][j] * rs[ai][m], up = acc[ai][1][m][n][j] * rs[ai][m]; v[n * 4 + j] = g * sigm(g) * up; }
                u32x4 w; w.x = cvt_pk_bf16(v[0], v[1]); w.y = cvt_pk_bf16(v[2], v[3]); w.z = cvt_pk_bf16(v[4], v[5]); w.w = cvt_pk_bf16(v[6], v[7]);
                __builtin_nontemporal_store(w, (PG8_GAS u32x4*)rowp); }
    }
};
struct EpiPle {
    static constexpr bool PERM = true, AFTER_DRAIN = false;
    bf16_t* O; const bf16_t* PP; int ldc; const float* rsc;
    __device__ __forceinline__ void pre(const Unit& u, int wr, int fr, float (&rsp)[8]) const { const int row0 = u.pm * BM + wr * 64 + fr;
#pragma unroll
        for (int i = 0; i < 8; ++i) rsp[i] = rsc ? ((const PG8_GAS float*)rsc)[row0 + (i >> 2) * HALF + (i & 3) * 16] : 1.0f; }
    __device__ __forceinline__ void operator()(const f32x4 (&acc)[2][2][4][2], const Unit& u, int wr, int wc, int fr, int fq, const float (&rsp)[8]) const {
        const int row0 = u.pm * BM + wr * 64 + fr, col0 = u.pn * BM + wc * 32 + 8 * fq;
#pragma unroll
        for (int ai = 0; ai < 2; ++ai)
#pragma unroll
            for (int m = 0; m < 4; ++m) { const size_t off = (size_t)(row0 + ai * HALF + m * 16) * ldc + col0; const float rsv = rsp[ai * 4 + m];
#pragma unroll
                for (int bj = 0; bj < 2; ++bj) { const u32x4 pw = *(const PG8_GAS u32x4*)(PP + off + bj * HALF); const f32x4 a0 = acc[ai][bj][m][0] * rsv, a1 = acc[ai][bj][m][1] * rsv;
                    u32x4 w;
                    w.x = cvt_pk_bf16(sigm(a0[0]) * __uint_as_float(pw.x << 16), sigm(a0[1]) * __uint_as_float(pw.x & 0xffff0000u));
                    w.y = cvt_pk_bf16(sigm(a0[2]) * __uint_as_float(pw.y << 16), sigm(a0[3]) * __uint_as_float(pw.y & 0xffff0000u));
                    w.z = cvt_pk_bf16(sigm(a1[0]) * __uint_as_float(pw.z << 16), sigm(a1[1]) * __uint_as_float(pw.z & 0xffff0000u));
                    w.w = cvt_pk_bf16(sigm(a1[2]) * __uint_as_float(pw.w << 16), sigm(a1[3]) * __uint_as_float(pw.w & 0xffff0000u));
                    __builtin_nontemporal_store(w, (PG8_GAS u32x4*)(O + off + bj * HALF)); } }
    }
};
template <class Epi, class Sched, bool ALIGN_EPI = false, bool SP2 = false>
__device__ __forceinline__ void gemm_phase(PG8_LAS unsigned char* lds, const Gemm g, const Sched& S, const Epi& E) {
    int tid_o = threadIdx.x; asm volatile("" : "+v"(tid_o));
    const int tid = tid_o, wid = __builtin_amdgcn_readfirstlane(tid >> 6), lane = tid & 63, wr = wid >> 2, wc = wid & 3, fr = lane & 15, fq = lane >> 4;
    const int K = g.K, nt = K / BK;
    unsigned voffA[2], voffB[2];
#pragma unroll
    for (int i = 0; i < 2; ++i) { int R, C; stage_rc(tid * 16 + i * 8192, R, C); const int Rb = Epi::PERM ? ((R & ~31) + perm32(R & 31)) : R;
        voffA[i] = (unsigned)(R * K + C) * 2u; voffB[i] = (unsigned)(Rb * K + C) * 2u; }
    const size_t kstep = (size_t)(BK * 2);
    const size_t hstep = (size_t)HALF * K * 2;
    const size_t tstep = 2 * hstep;
    const unsigned ldsw = (unsigned)wid * 1024u;
    const int aoff = lds_byte(wr * 64 + fr, fq * 8), boff = lds_byte(wc * 32 + fr, fq * 8);
#define PG8_SA(b, h) (((b) * 2 + (h)) * HTB)
#define PG8_SB(b, h) ((4 + (b) * 2 + (h)) * HTB)
#define PG8_STAGE(bufoff, gbase, voff) do { _Pragma("unroll") for (int _i = 0; _i < 2; ++_i) \
        __builtin_amdgcn_global_load_lds((const unsigned*)((const char*)(gbase) + (voff)[_i]), (PG8_LAS unsigned*)(lds + (bufoff) + ldsw + _i * 8192), 16, 0, 0); } while (0)
#define PG8_LDA(dst, b, h) do { _Pragma("unroll") for (int m = 0; m < 4; ++m) _Pragma("unroll") for (int k = 0; k < 2; ++k) dst[m][k] = *(const PG8_LAS bf16x8*)(lds + PG8_SA(b, h) + aoff + m * 2048 + k * 1024); } while (0)
#define PG8_LDB(dst, b, h) do { _Pragma("unroll") for (int n = 0; n < 2; ++n) _Pragma("unroll") for (int k = 0; k < 2; ++k) dst[n][k] = *(const PG8_LAS bf16x8*)(lds + PG8_SB(b, h) + boff + n * 2048 + k * 1024); } while (0)
#define PG8_MMA(ai, bj, At, Bt) do { __builtin_amdgcn_s_setprio(1); _Pragma("unroll") for (int m = 0; m < 4; ++m) _Pragma("unroll") for (int n = 0; n < 2; ++n) _Pragma("unroll") for (int k = 0; k < 2; ++k) \
        acc[ai][bj][m][n] = __builtin_amdgcn_mfma_f32_16x16x32_bf16(Bt[n][k], At[m][k], acc[ai][bj][m][n], 0, 0, 0); __builtin_amdgcn_s_setprio(0); } while (0)
#define PG8_WAIT_V(n) asm volatile("s_waitcnt vmcnt(" #n ")" ::: "memory")
#define PG8_WAIT_L(n) asm volatile("s_waitcnt lgkmcnt(" #n ")" ::: "memory")
#define PG8_BAR __builtin_amdgcn_s_barrier()
#define PG8_SCHED __builtin_amdgcn_sched_barrier(0)
    Unit cur, nxt; int ui = 0;
    if (!S.next(0, cur)) return;
    f32x4 acc[2][2][4][2];
#pragma unroll
    for (int a = 0; a < 2; ++a)
#pragma unroll
        for (int b = 0; b < 2; ++b)
#pragma unroll
            for (int m = 0; m < 4; ++m)
#pragma unroll
                for (int n = 0; n < 2; ++n) acc[a][b][m][n] = (f32x4){0.f, 0.f, 0.f, 0.f};
    bf16x8 At[4][2], B0[2][2], B1[2][2];
    const char* cA = (const char*)g.A + (size_t)cur.pm * tstep; const char* cB = (const char*)g.Bt + (size_t)cur.pn * tstep;
    S.a_ready(cur);
    if constexpr (SP2) {
        PG8_STAGE(PG8_SB(0, 0), cB, voffB); PG8_STAGE(PG8_SB(0, 1), cB + hstep, voffB); PG8_STAGE(PG8_SA(0, 0), cA, voffA); PG8_STAGE(PG8_SA(0, 1), cA + hstep, voffA);
        if (wr == 1) PG8_BAR;
        PG8_WAIT_V(2); PG8_BAR;
        PG8_STAGE(PG8_SB(1, 0), cB + kstep, voffB); PG8_STAGE(PG8_SA(1, 0), cA + kstep, voffA); PG8_STAGE(PG8_SB(1, 1), cB + hstep + kstep, voffB);
        PG8_WAIT_V(6); PG8_BAR;
    } else {
        PG8_STAGE(PG8_SB(0, 0), cB, voffB); PG8_STAGE(PG8_SA(0, 0), cA, voffA); PG8_STAGE(PG8_SB(0, 1), cB + hstep, voffB); PG8_STAGE(PG8_SA(0, 1), cA + hstep, voffA);
        if (wr == 1) PG8_BAR;
        PG8_WAIT_V(4); PG8_BAR;
        PG8_STAGE(PG8_SB(1, 0), cB + kstep, voffB); PG8_STAGE(PG8_SA(1, 0), cA + kstep, voffA); PG8_STAGE(PG8_SB(1, 1), cB + hstep + kstep, voffB);
        PG8_WAIT_V(6); PG8_BAR;
    }
    for (;;) {
        const bool has_next = S.next(ui + 1, nxt);
        float rsp[8]; E.pre(cur, wr, fr, rsp);
        const char* nA = has_next ? (const char*)g.A + (size_t)nxt.pm * tstep : cA; const char* nB = has_next ? (const char*)g.Bt + (size_t)nxt.pn * tstep : cB;
        for (int t = 0; t < nt; t += 2) {
            const bool last = (t == nt - 2);
            const char* a1 = cA + (size_t)(t + 1) * kstep;
            const char* a2 = last ? nA : cA + (size_t)(t + 2) * kstep; const char* b2 = last ? nB : cB + (size_t)(t + 2) * kstep;
            const char* a3 = a2 + kstep; const char* b3 = b2 + kstep;
            if (last && has_next) S.a_ready(nxt);
            if constexpr (SP2) {
            PG8_LDB(B0, 0, 0); PG8_LDB(B1, 0, 1); PG8_SCHED; PG8_LDA(At, 0, 0); PG8_STAGE(PG8_SA(1, 1), a1 + hstep, voffA);
            PG8_WAIT_V(8); PG8_WAIT_L(0); PG8_BAR; PG8_MMA(0, 0, At, B0); PG8_MMA(0, 1, At, B1); PG8_BAR; PG8_SCHED;
            PG8_LDA(At, 0, 1); PG8_STAGE(PG8_SB(0, 0), b2, voffB); PG8_STAGE(PG8_SB(0, 1), b2 + hstep, voffB); PG8_STAGE(PG8_SA(0, 0), a2, voffA);
            PG8_WAIT_V(8); PG8_WAIT_L(0); PG8_BAR; PG8_MMA(1, 0, At, B0); PG8_MMA(1, 1, At, B1); PG8_BAR; PG8_SCHED;
            PG8_LDB(B0, 1, 0); PG8_LDB(B1, 1, 1); PG8_SCHED; PG8_LDA(At, 1, 0); PG8_STAGE(PG8_SA(0, 1), a2 + hstep, voffA);
            PG8_WAIT_V(8); PG8_WAIT_L(0); PG8_BAR; PG8_MMA(0, 0, At, B0); PG8_MMA(0, 1, At, B1); PG8_BAR; PG8_SCHED;
            PG8_LDA(At, 1, 1); PG8_STAGE(PG8_SB(1, 0), b3, voffB); PG8_STAGE(PG8_SB(1, 1), b3 + hstep, voffB); PG8_STAGE(PG8_SA(1, 0), a3, voffA);
            PG8_WAIT_V(8); PG8_WAIT_L(0); PG8_BAR; PG8_MMA(1, 0, At, B0); PG8_MMA(1, 1, At, B1); PG8_BAR; PG8_SCHED;
            } else {
            PG8_LDB(B0, 0, 0); PG8_SCHED; PG8_LDA(At, 0, 0); PG8_STAGE(PG8_SA(1, 1), a1 + hstep, voffA);
            PG8_WAIT_L(8); PG8_BAR; PG8_WAIT_L(0); PG8_MMA(0, 0, At, B0); PG8_BAR; PG8_SCHED;
            PG8_LDB(B1, 0, 1); PG8_STAGE(PG8_SB(0, 0), b2, voffB);
            PG8_BAR; PG8_WAIT_L(0); PG8_MMA(0, 1, At, B1); PG8_BAR;
            PG8_LDA(At, 0, 1); PG8_STAGE(PG8_SA(0, 0), a2, voffA);
            PG8_BAR; PG8_WAIT_L(0); PG8_MMA(1, 0, At, B0); PG8_BAR; PG8_SCHED;
            PG8_STAGE(PG8_SB(0, 1), b2 + hstep, voffB);
            PG8_WAIT_V(6); PG8_BAR; PG8_MMA(1, 1, At, B1); PG8_BAR;
            PG8_LDB(B0, 1, 0); PG8_SCHED; PG8_LDA(At, 1, 0); PG8_STAGE(PG8_SA(0, 1), a2 + hstep, voffA);
            PG8_WAIT_L(8); PG8_BAR; PG8_WAIT_L(0); PG8_MMA(0, 0, At, B0); PG8_BAR; PG8_SCHED;
            PG8_LDB(B1, 1, 1); PG8_STAGE(PG8_SB(1, 0), b3, voffB);
            PG8_BAR; PG8_WAIT_L(0); PG8_MMA(0, 1, At, B1); PG8_BAR;
            PG8_LDA(At, 1, 1); PG8_STAGE(PG8_SA(1, 0), a3, voffA);
            PG8_BAR; PG8_WAIT_L(0); PG8_MMA(1, 0, At, B0); PG8_BAR; PG8_SCHED;
            PG8_STAGE(PG8_SB(1, 1), b3 + hstep, voffB);
            PG8_WAIT_V(6); PG8_BAR; PG8_MMA(1, 1, At, B1); PG8_BAR;
            }
        }
        if constexpr (ALIGN_EPI) { if (wr == 0) PG8_BAR; }
        if constexpr (!Epi::AFTER_DRAIN) { E(acc, cur, wr, wc, fr, fq, rsp); S.done(cur); }
        if (!has_next) break;
#pragma unroll
        for (int a = 0; a < 2; ++a)
#pragma unroll
            for (int b = 0; b < 2; ++b)
#pragma unroll
                for (int m = 0; m < 4; ++m)
#pragma unroll
                    for (int n = 0; n < 2; ++n) acc[a][b][m][n] = (f32x4){0.f, 0.f, 0.f, 0.f};
        cur = nxt; cA = nA; cB = nB; ++ui;
        if constexpr (ALIGN_EPI) { if (wr == 1) PG8_BAR; }
    }
    PG8_WAIT_V(0);
    if constexpr (!ALIGN_EPI) { if (wr == 0) PG8_BAR; }
    PG8_BAR;
    if constexpr (Epi::AFTER_DRAIN) { E.fused(acc, cur, wr, wc, fr, fq, lds, wid, lane); S.done(cur); }
#undef PG8_SA
#undef PG8_SB
#undef PG8_STAGE
#undef PG8_LDA
#undef PG8_LDB
#undef PG8_MMA
#undef PG8_WAIT_V
#undef PG8_WAIT_L
#undef PG8_BAR
#undef PG8_SCHED
}
}

#ifndef MK_SPLIT
#define MK_SPLIT 0
#endif
#define DEVI __device__ __forceinline__
#define LAS __attribute__((address_space(3)))
#define GAS __attribute__((address_space(1)))
typedef unsigned short bf16;
typedef float f32x4 __attribute__((ext_vector_type(4)));
typedef float f32x16 __attribute__((ext_vector_type(16)));
typedef short bf16x8 __attribute__((ext_vector_type(8)));
typedef short s16x4 __attribute__((ext_vector_type(4)));
typedef short v4i16_t __attribute__((ext_vector_type(4)));
typedef unsigned u32x4 __attribute__((ext_vector_type(4)));
typedef unsigned u32x2 __attribute__((ext_vector_type(2)));
typedef GAS unsigned gu32;

constexpr int NWAVES = 8, NTHR = 512;
constexpr int BATCH = 2, SEQ = 8192, M = BATCH * SEQ, DM = 4096, DFF = 11008, DEPTH = 2;
constexpr int NIN = 10824, NINP = 11008;
constexpr int C_RQ = 0, C_RK = 1024, C_RV = 2048, C_RG = 3072, C_CQ = 4096, C_CKV = 5120, C_KR = 5632, C_FQ = 5696, C_FK = 6720, C_FV = 7744, C_FF = 8768, C_CIN = 8776;
constexpr float NORM_EPS = 1e-6f, LN_EPS = 1e-5f;
constexpr float LOG2E = 1.4426950408889634f;

constexpr size_t MiB = 1u << 20;
constexpr size_t WS_CTL = 0, CTL_ZERO_BYTES = 1 * MiB;
constexpr size_t WS_WGU1 = 1 * MiB, WS_WD1 = 173 * MiB, WS_WGU2 = 259 * MiB, WS_WD2 = 431 * MiB, WS_WIN = 517 * MiB, WS_WOUT = 603 * MiB, WS_WPG = 635 * MiB,
                 WS_WPP = 667 * MiB, WS_WUQ = 669 * MiB, WS_WUKV = 672 * MiB, WS_WPW = 674 * MiB;
constexpr size_t WS_HN = 676 * MiB, WS_ACT = 804 * MiB, WS_Y = 1148 * MiB, WS_CAT = 1404 * MiB, WS_PPB = 1532 * MiB, WS_P16 = 1660 * MiB;
constexpr size_t WS_COS128 = 1676 * MiB, WS_SIN128 = 1680 * MiB, WS_COS64 = 1684 * MiB, WS_SIN64 = 1686 * MiB;
constexpr size_t WS_RQ = 1688 * MiB, WS_RK = 1720 * MiB, WS_CQN = 1752 * MiB, WS_CKVN = 1784 * MiB, WS_KR = 1800 * MiB, WS_LOGF = 1802 * MiB, WS_CUM2 = 1803 * MiB,
                 WS_U = 1804 * MiB, WS_YC = 1836 * MiB, WS_MQ = 1868 * MiB, WS_KVR = 1916 * MiB, WS_KVC = 1980 * MiB, WS_ST = 2044 * MiB, WS_H16 = 2076 * MiB, WS_RS = 2204 * MiB, WS_END = 2205 * MiB;
constexpr int CW_BAR = 4096;
constexpr int CW_QK = 16384;

constexpr int RING_BYTES = 131072, LDSCTL_OFF = RING_BYTES, LDS_BYTES = 147456;

#define LDS_WAIT() asm volatile("s_waitcnt lgkmcnt(0)" ::: "memory")
DEVI float bf2f(unsigned b) { return __uint_as_float(b << 16); }
DEVI unsigned f2bf(float f) { unsigned u = __float_as_uint(f); return (u + 0x7fffu + ((u >> 16) & 1u)) >> 16; }
DEVI unsigned pk2(float lo, float hi) { return pg8::cvt_pk_bf16(lo, hi); }
DEVI void unpack8(const u32x4 w, float (&f)[8]) {
    f[0] = __uint_as_float(w.x << 16); f[1] = __uint_as_float(w.x & 0xffff0000u); f[2] = __uint_as_float(w.y << 16); f[3] = __uint_as_float(w.y & 0xffff0000u);
    f[4] = __uint_as_float(w.z << 16); f[5] = __uint_as_float(w.z & 0xffff0000u); f[6] = __uint_as_float(w.w << 16); f[7] = __uint_as_float(w.w & 0xffff0000u); }
DEVI u32x4 pack8(const float (&f)[8]) { u32x4 w; w.x = pk2(f[0], f[1]); w.y = pk2(f[2], f[3]); w.z = pk2(f[4], f[5]); w.w = pk2(f[6], f[7]); return w; }
DEVI float wave_sum(float v) {
#pragma unroll
    for (int o = 1; o < 64; o <<= 1) v += __shfl_xor(v, o);
    return v; }
DEVI float sigm(float x) { return __builtin_amdgcn_rcpf(1.0f + __builtin_amdgcn_exp2f(-LOG2E * x)); }
template <int MASK> DEVI float shxor(float v) { static_assert(MASK > 0 && MASK < 32, "ds_swizzle bit mode"); return __builtin_bit_cast(float, __builtin_amdgcn_ds_swizzle(__builtin_bit_cast(int, v), (MASK << 10) | 0x1f)); }
DEVI float max32(float v) { unsigned a = __builtin_bit_cast(unsigned, v), b = a; asm volatile("s_nop 1\n\tv_permlane32_swap_b32 %0, %1" : "+v"(a), "+v"(b)); return fmaxf(__builtin_bit_cast(float, a), __builtin_bit_cast(float, b)); }
DEVI float wave_max(float v) { v = fmaxf(v, shxor<1>(v)); v = fmaxf(v, shxor<2>(v)); v = fmaxf(v, shxor<4>(v)); v = fmaxf(v, shxor<8>(v)); v = fmaxf(v, shxor<16>(v)); return max32(v); }
DEVI int crow(int r, int hi) { return (r & 3) + 8 * (r >> 2) + 4 * hi; }
DEVI s16x4 vtr(const LAS unsigned char* p) { return __builtin_bit_cast(s16x4, __builtin_amdgcn_ds_read_tr16_b64_v4i16((LAS v4i16_t*)p)); }
DEVI bf16x8 cat44(s16x4 a, s16x4 b) { return (bf16x8){a[0], a[1], a[2], a[3], b[0], b[1], b[2], b[3]}; }
DEVI bf16x8 packp8(const f32x16& p, int s) { u32x4 w; w.x = pg8::cvt_pk_bf16(p[8 * s + 0], p[8 * s + 1]); w.y = pg8::cvt_pk_bf16(p[8 * s + 2], p[8 * s + 3]);
    w.z = pg8::cvt_pk_bf16(p[8 * s + 4], p[8 * s + 5]); w.w = pg8::cvt_pk_bf16(p[8 * s + 6], p[8 * s + 7]); return __builtin_bit_cast(bf16x8, w); }
#define MFMA32(a, b, c) __builtin_amdgcn_mfma_f32_32x32x16_bf16((a), (b), (c), 0, 0, 0)

DEVI unsigned long long rfl64(unsigned long long v) { const unsigned lo = __builtin_amdgcn_readfirstlane((unsigned)v), hi = __builtin_amdgcn_readfirstlane((unsigned)(v >> 32)); return ((unsigned long long)hi << 32) | lo; }
#define XB_TMO      128
#define XB_XCNT(j)  (256  + 64 * (j))
#define XB_XSUB(j)  (1280 + 64 * (j))
#define XB_XGEN(j)  (2304 + 64 * (j))
#define XB_TOP      3328
#define XB_TOPGEN   3392
#define XCD_BAR_WORDS 3456
#define XB_SPIN_CAP (1u << 18)

__device__ __forceinline__ unsigned xb_ld(unsigned* p)              { return __hip_atomic_load(p, __ATOMIC_RELAXED, __HIP_MEMORY_SCOPE_AGENT); }
__device__ __forceinline__ unsigned xb_add(unsigned* p, unsigned v) { return __hip_atomic_fetch_add(p, v, __ATOMIC_RELAXED, __HIP_MEMORY_SCOPE_AGENT); }
__device__ __forceinline__ unsigned xb_xcc_id() { return (unsigned)__builtin_amdgcn_s_getreg((3 << 11) | 20) & 0xFu; }
#define XB_SPIN(cond, bar) do { unsigned _sp = 0; while (cond) { __builtin_amdgcn_s_sleep(1); \
    if ((++_sp & 255u) == 0u) { if (xb_ld(&(bar)[XB_TMO])) break; if (_sp > XB_SPIN_CAP) { atomicAdd(&(bar)[XB_TMO], 1u); break; } } } } while (0)

struct XcdBarrier {
    unsigned* bar; unsigned x;
    volatile LAS unsigned* st;
};

__device__ __forceinline__ XcdBarrier xcd_barrier_post(unsigned* bar, volatile LAS unsigned* st) {
    XcdBarrier b; b.bar = bar; b.x = xb_xcc_id(); b.st = st;
    if (threadIdx.x == 0) (void)xb_add(&bar[XB_XCNT(b.x)], 1u);
    return b;
}
__device__ __forceinline__ void xcd_barrier_complete(unsigned* bar, unsigned x, unsigned& nloc, unsigned& nx) {
    const unsigned G = gridDim.x * gridDim.y * gridDim.z;
    unsigned sum, cnt, mine, sp = 0u;
    for (;;) {
        sum = 0u; cnt = 0u; mine = 0u;
#pragma unroll
        for (unsigned j = 0; j < 16; ++j) { const unsigned c = xb_ld(&bar[XB_XCNT(j)]); sum += c; cnt += (c > 0u) ? 1u : 0u; mine = (j == x) ? c : mine; }
        if (sum == G) break;
        __builtin_amdgcn_s_sleep(1);
        if ((++sp & 255u) == 0u) { if (xb_ld(&bar[XB_TMO])) break; if (sp > XB_SPIN_CAP) { atomicAdd(&bar[XB_TMO], 1u); break; } }
    }
    nloc = mine > 0u ? mine : 1u; nx = cnt > 0u ? cnt : 1u;
}

__device__ __forceinline__ void xcd_barrier(const XcdBarrier& b) {
    asm volatile("s_waitcnt vmcnt(0)" ::: "memory");
    __syncthreads();
    if (threadIdx.x == 0) {
        unsigned* bar = b.bar;
        __builtin_amdgcn_s_waitcnt(0);
        unsigned nloc = b.st[0], nx = b.st[1];
        if (nloc == 0u) { xcd_barrier_complete(bar, b.x, nloc, nx); b.st[0] = nloc; b.st[1] = nx; }
        const unsigned old = xb_add(&bar[XB_XSUB(b.x)], 1u);
        const unsigned gen = old / nloc;
        if (old + 1u == (gen + 1u) * nloc) {
            __builtin_amdgcn_fence(__ATOMIC_RELEASE, "agent");
            asm volatile("s_waitcnt vmcnt(0)" ::: "memory");
            const unsigned og = xb_add(&bar[XB_TOP], 1u);
            const unsigned tg = og / nx;
            if (og + 1u == (tg + 1u) * nx) xb_add(&bar[XB_TOPGEN], 1u);
            else XB_SPIN(xb_ld(&bar[XB_TOPGEN]) == tg, bar);
            __builtin_amdgcn_fence(__ATOMIC_ACQUIRE, "agent");
            xb_add(&bar[XB_XGEN(b.x)], 1u);
            asm volatile("s_waitcnt vmcnt(0)" ::: "memory");
        } else {
            XB_SPIN(xb_ld(&bar[XB_XGEN(b.x)]) == gen, bar);
            __builtin_amdgcn_fence(__ATOMIC_ACQUIRE, "agent");
            asm volatile("s_waitcnt vmcnt(0)" ::: "memory");
        }
    }
    __syncthreads();
}

DEVI void tr_item(const float* __restrict__ W, int K, int N, bf16* __restrict__ WT, int dst_row0, LAS float* scr, int k0, int n0, int lane, const float* __restrict__ gk = nullptr) {
    const int c = lane & 31; const bool ok = (n0 + c) < N;
#pragma unroll
    for (int i = 0; i < 32; ++i) { const int kk = 2 * i + (lane >> 5); scr[kk * 33 + c] = ok ? W[(size_t)(k0 + kk) * N + n0 + c] : 0.f; }
    LDS_WAIT(); asm volatile("" ::: "memory");
    const int ch = lane & 7;
    f32x4 g0 = {1.f, 1.f, 1.f, 1.f}, g1 = g0; if (gk) { g0 = *(const f32x4*)(gk + k0 + 8 * ch); g1 = *(const f32x4*)(gk + k0 + 8 * ch + 4); }
#pragma unroll
    for (int j = 0; j < 4; ++j) { const int n = (lane >> 3) + 8 * j; const LAS float* s = scr + (8 * ch) * 33 + n;
        u32x4 o; o.x = pk2(s[0 * 33] * g0[0], s[1 * 33] * g0[1]); o.y = pk2(s[2 * 33] * g0[2], s[3 * 33] * g0[3]); o.z = pk2(s[4 * 33] * g1[0], s[5 * 33] * g1[1]); o.w = pk2(s[6 * 33] * g1[2], s[7 * 33] * g1[3]);
        *(u32x4*)(WT + (size_t)(dst_row0 + n) * K + k0 + 8 * ch) = o; }
    LDS_WAIT(); asm volatile("" ::: "memory");
}

template <bool FIRST, bool LAST, bool HAS_HN>
DEVI void norm_row(const void* __restrict__ hin, void* __restrict__ hout, const bf16* __restrict__ y, float coef, const float* __restrict__ gpost, float* __restrict__ hn  , int lane) {
    f32x4 v[16];
    asm volatile("" : "+s"(gpost));
    if (FIRST) {
#pragma unroll
        for (int j = 0; j < 16; ++j) v[j] = ((const f32x4*)hin)[lane + 64 * j];
    } else {
        u32x2 yw[16], hw[16]; float ss = 0.f;
#pragma unroll
        for (int j = 0; j < 16; ++j) yw[j] = ((const u32x2*)y)[lane + 64 * j];
#pragma unroll
        for (int j = 0; j < 16; ++j) hw[j] = ((const u32x2*)hin)[lane + 64 * j];
#pragma unroll
        for (int j = 0; j < 16; ++j) { const float a = __uint_as_float(yw[j].x << 16), b = __uint_as_float(yw[j].x & 0xffff0000u), c = __uint_as_float(yw[j].y << 16), d = __uint_as_float(yw[j].y & 0xffff0000u); ss += (a * a + b * b) + (c * c + d * d); }
        const float rs = coef / sqrtf(wave_sum(ss) * (1.0f / DM) + NORM_EPS);
#pragma unroll
        for (int j = 0; j < 16; ++j) { const f32x4 g = ((const f32x4*)gpost)[lane + 64 * j];
            const f32x4 yv = (f32x4){__uint_as_float(yw[j].x << 16), __uint_as_float(yw[j].x & 0xffff0000u), __uint_as_float(yw[j].y << 16), __uint_as_float(yw[j].y & 0xffff0000u)};
            const f32x4 hv = (f32x4){__uint_as_float(hw[j].x << 16), __uint_as_float(hw[j].x & 0xffff0000u), __uint_as_float(hw[j].y << 16), __uint_as_float(hw[j].y & 0xffff0000u)};
            v[j] = hv + yv * rs * g;
            if ((j & 3) == 3) { asm volatile("" : "+v"(v[j - 3]), "+v"(v[j - 2]), "+v"(v[j - 1]), "+v"(v[j]) :: "memory"); } }
    }
    if (LAST) {
#pragma unroll
        for (int j = 0; j < 16; ++j) ((f32x4*)hout)[lane + 64 * j] = v[j];
    } else {
#pragma unroll
        for (int j = 0; j < 16; ++j) { u32x2 o; o.x = pk2(v[j].x, v[j].y); o.y = pk2(v[j].z, v[j].w); ((u32x2*)hout)[lane + 64 * j] = o; }
    }
    if (HAS_HN) {
        float ss = 0.f;
#pragma unroll
        for (int j = 0; j < 16; ++j) ss += (v[j].x * v[j].x + v[j].y * v[j].y) + (v[j].z * v[j].z + v[j].w * v[j].w);
        const float rs = 1.0f / sqrtf(wave_sum(ss) * (1.0f / DM) + NORM_EPS);
        if (lane == 0) *(float*)hn = rs;
    }
    asm volatile("" ::: "memory");
}

DEVI void sincos_d(float ang, float& s_out, float& c_out) {
    const double a = (double)ang; const double q = __builtin_rint(a * 0.63661977236758134308);
    double y = __builtin_fma(-q, 1.57079632679489655800, a); y = __builtin_fma(-q, 6.123233995736766036e-17, y);
    const double y2 = y * y;
    double sp = 1.0 / 6227020800.0; sp = sp * y2 - 1.0 / 39916800.0; sp = sp * y2 + 1.0 / 362880.0; sp = sp * y2 - 1.0 / 5040.0; sp = sp * y2 + 1.0 / 120.0; sp = sp * y2 - 1.0 / 6.0; sp = sp * y2 + 1.0; sp = sp * y;
    double cp = -1.0 / 87178291200.0; cp = cp * y2 + 1.0 / 479001600.0; cp = cp * y2 - 1.0 / 3628800.0; cp = cp * y2 + 1.0 / 40320.0; cp = cp * y2 - 1.0 / 720.0; cp = cp * y2 + 1.0 / 24.0; cp = cp * y2 - 0.5; cp = cp * y2 + 1.0;
    const int qi = ((int)q) & 3;
    const double s = (qi == 0) ? sp : (qi == 1) ? cp : (qi == 2) ? -sp : -cp;
    const double c = (qi == 0) ? cp : (qi == 1) ? -sp : (qi == 2) ? -cp : sp;
    s_out = (float)s; c_out = (float)c;
}
DEVI float inv_freq(int i, double base) { double r = 1.0, b = base;
#pragma unroll
    for (int bit = 0; bit < 6; ++bit) { if ((i >> bit) & 1) r *= b; b *= b; }
    return (float)r; }
DEVI float ret_lg2(int h) {
    const double x = 1.0 / (double)(1 << (5 + h)); double t = x, s = 0.0;
#pragma unroll
    for (int k = 1; k <= 12; ++k) { s += t / (double)k; t *= x; }
    return (float)(-s * 1.4426950408889634074);
}

template <int DK, bool FOX>
DEVI void attn_unit(LAS unsigned char* lds, int b, int qb, const bf16* __restrict__ Qp, int qpitch, const bf16* __restrict__ K1p, int k1pitch, const bf16* __restrict__ K2p, int k2pitch,
                    const bf16* __restrict__ Vp, int vpitch, const float* __restrict__ cum2, bf16* __restrict__ Op, int opitch, float c2, float qkmax2) {
    constexpr int KSTR = (DK == 128) ? 272 : 400, VSTR = 320, NCH = DK / 8, NDS = DK / 16, NPARK = 0, NPRING = 0;
    int tid_o = threadIdx.x; asm volatile("" : "+v"(tid_o));
    const int tid = tid_o, w = __builtin_amdgcn_readfirstlane(tid >> 6), lane = tid & 63, r32 = lane & 31, hi = lane >> 5;
    const int t = qb * 256 + w * 32 + r32;
    const size_t mq = (size_t)b * SEQ + t;
    constexpr int NQR = NDS - NPARK;
    bf16x8 qf[NQR];
#pragma unroll
    for (int ds = 0; ds < NQR; ++ds) qf[ds] = *(const bf16x8*)(Qp + mq * qpitch + 16 * ds + 8 * hi);
    static_assert(3 * (64 * KSTR + 256) + 2 * (64 * VSTR) + 8 * NPRING * 1024 <= RING_BYTES && 2048 + 8 * (NPARK - NPRING) * 1024 <= LDS_BYTES - LDSCTL_OFF, "attention LDS budget");
    LAS unsigned char* qpark = lds + 3 * (64 * KSTR + 256) + 2 * (64 * VSTR) + w * (NPRING * 1024) + lane * 16;
    LAS unsigned char* qpark2 = lds + LDSCTL_OFF + 2048 + w * ((NPARK - NPRING) * 1024) + lane * 16;
    {
#pragma unroll
        for (int ds = NQR; ds < NDS; ++ds) *(LAS bf16x8*)((ds - NQR < NPRING) ? qpark + (ds - NQR) * 1024 : qpark2 + (ds - NQR - NPRING) * 1024) = *(const bf16x8*)(Qp + mq * qpitch + 16 * ds + 8 * hi); }
    float ct2 = 0.f; if (FOX) ct2 = cum2[t];
    f32x16 o[4];
#pragma unroll
    for (int d0 = 0; d0 < 4; ++d0)
#pragma unroll
        for (int r = 0; r < 16; ++r) o[d0][r] = 0.f;
    float m_run = -1e30f, l_run = 0.f;
    const int NT = 4 * (qb + 1), jlast = 4 * qb + (w >> 1);
    const int qfirst = qb * 256 + w * 32;
    int j0 = 0;
    if (FOX) { const float thr = -(2.0f * qkmax2 + 64.0f), cT0 = cum2[qb * 256];
        const int ja = lane, jb = lane + 64;
        const bool da = (ja < NT) && (cT0 - cum2[64 * ja + 63] < thr), db = (jb < NT) && (cT0 - cum2[64 * jb + 63] < thr);
        j0 = __builtin_popcountll(__ballot(da)) + __builtin_popcountll(__ballot(db)); j0 = __builtin_amdgcn_readfirstlane(j0); if (j0 > 4 * qb) j0 = 4 * qb; }
    const size_t mk0 = (size_t)b * SEQ;
    constexpr int KB = 64 * KSTR + 256, VB = 64 * VSTR;
    constexpr int KSPR = KSTR / 16, VSPR = VSTR / 16, NIK = 64 * KSPR / 64, NIV = 64 * VSPR / 64, NKD = (NIK + 7) / 8, NVD = (NIV + 7) / 8;
    constexpr int NKOPS = NKD + (FOX ? 1 : 0), NVOPS = NVD;
    unsigned koff[NKD], voff[NVD]; unsigned k2mask = 0u;
#pragma unroll
    for (int i = 0; i < NKD; ++i) { int n = w + 8 * i; if (n >= NIK) n -= 8; const int s_ = 64 * n + lane, row = s_ / KSPR; int ch = s_ % KSPR; if (ch >= NCH) ch = 0;
        if (ch < 16) koff[i] = (unsigned)(row * k1pitch + ch * 8) * 2u; else { koff[i] = (unsigned)(row * k2pitch + (ch - 16) * 8) * 2u; k2mask |= 1u << i; } }
#pragma unroll
    for (int i = 0; i < NVD; ++i) { int n = w + 8 * i; if (n >= NIV) n -= 8; const int s_ = 64 * n + lane, row = s_ / VSPR; int ch = s_ % VSPR; if (ch >= 16) ch = 0; voff[i] = (unsigned)(row * vpitch + ch * 8) * 2u; }
#define ATT_DMAK(tt) do { const int t_ = (tt) < NTt ? (tt) : NTt - 1; const int j_ = j0 + t_; LAS unsigned char* Kw = lds + ((tt) % 3) * KB; \
        const GAS char* kb1 = (const GAS char*)(K1p + (mk0 + 64 * j_) * k1pitch); const GAS char* kb2 = (const GAS char*)(K2p + (mk0 + 64 * j_) * k2pitch); \
        _Pragma("unroll") for (int i = 0; i < NKD; ++i) { int n = w + 8 * i; if (n >= NIK) n -= 8; const GAS char* sp_ = ((k2mask >> i) & 1u) ? kb2 + koff[i] : kb1 + koff[i]; \
            __builtin_amdgcn_global_load_lds((const GAS unsigned*)sp_, (LAS unsigned*)(Kw + n * 1024), 16, 0, 0); } \
        if (FOX) __builtin_amdgcn_global_load_lds((const GAS unsigned*)((const GAS float*)cum2 + 64 * j_ + lane), (LAS unsigned*)(Kw + 64 * KSTR), 4, 0, 0); } while (0)
#define ATT_DMAV(tt) do { const int t_ = (tt) < NTt ? (tt) : NTt - 1; LAS unsigned char* Vw = lds + 3 * KB + ((tt) & 1) * VB; const GAS char* vb_ = (const GAS char*)(Vp + (mk0 + 64 * (j0 + t_)) * vpitch); \
        _Pragma("unroll") for (int i = 0; i < NVD; ++i) { int n = w + 8 * i; if (n >= NIV) n -= 8; __builtin_amdgcn_global_load_lds((const GAS unsigned*)(vb_ + voff[i]), (LAS unsigned*)(Vw + n * 1024), 16, 0, 0); } } while (0)
#define ATT_WAITBAR(N) asm volatile("s_waitcnt vmcnt(%0) lgkmcnt(0)\n\ts_barrier" :: "n"(N) : "memory")
    const int NTt = NT - j0;
    f32x16 p0, p1;
#pragma unroll
    for (int r = 0; r < 16; ++r) { p0[r] = 0.f; p1[r] = 0.f; }
    asm volatile("s_waitcnt vmcnt(0) lgkmcnt(0)" ::: "memory"); __syncthreads();
    ATT_DMAK(0); ATT_DMAK(1); ATT_DMAV(0);
    ATT_WAITBAR(0);
    for (int tl = 0; tl < NTt; ++tl) { const int j = j0 + tl;
        ATT_DMAV(tl + 1); ATT_DMAK(tl + 2);
        if (j <= jlast) {
            const LAS unsigned char* Kt = lds + (tl % 3) * KB; const LAS float* cs = (const LAS float*)(Kt + 64 * KSTR);
            int ln1 = lane; asm volatile("" : "+v"(ln1));
            const LAS unsigned char* ka = Kt + (ln1 & 31) * KSTR + (ln1 >> 5) * 16;
            bf16x8 fa[2][4];
#define ATT_LOADP(bf_, pr_) do { fa[bf_][0] = *(const LAS bf16x8*)(ka + (2 * (pr_)) * 32); fa[bf_][1] = *(const LAS bf16x8*)(ka + 32 * KSTR + (2 * (pr_)) * 32); \
                                 fa[bf_][2] = *(const LAS bf16x8*)(ka + (2 * (pr_) + 1) * 32); fa[bf_][3] = *(const LAS bf16x8*)(ka + 32 * KSTR + (2 * (pr_) + 1) * 32); } while (0)
#define ATT_QV(ds_) (((ds_) < NQR) ? qf[(ds_) < NQR ? (ds_) : 0] : *(const LAS bf16x8*)(((ds_) - NQR < NPRING) ? qpark + ((ds_) - NQR) * 1024 : qpark2 + ((ds_) - NQR - NPRING) * 1024))
            ATT_LOADP(0, 0); ATT_LOADP(1, 1); __builtin_amdgcn_sched_barrier(0);
#pragma unroll
            for (int r = 0; r < 16; ++r) { p0[r] = 0.f; p1[r] = 0.f; }
#pragma unroll
            for (int pr = 0; pr < NDS / 2; ++pr) { const bf16x8 q0 = ATT_QV(2 * pr), q1 = ATT_QV(2 * pr + 1);
                p0 = MFMA32(fa[pr & 1][0], q0, p0); p1 = MFMA32(fa[pr & 1][1], q0, p1); p0 = MFMA32(fa[pr & 1][2], q1, p0); p1 = MFMA32(fa[pr & 1][3], q1, p1);
                __builtin_amdgcn_sched_barrier(0);
                if (pr + 2 < NDS / 2) { ATT_LOADP(pr & 1, pr + 2); __builtin_amdgcn_sched_barrier(0); } }
#undef ATT_LOADP
#undef ATT_QV
            if (FOX) {
#pragma unroll
                for (int g4 = 0; g4 < 4; ++g4) { const f32x4 c0 = *(const LAS f32x4*)(cs + 8 * g4 + 4 * hi), c1 = *(const LAS f32x4*)(cs + 32 + 8 * g4 + 4 * hi);
#pragma unroll
                    for (int e = 0; e < 4; ++e) { p0[4 * g4 + e] = __builtin_fmaf(p0[4 * g4 + e], c2, ct2 - c0[e]); p1[4 * g4 + e] = __builtin_fmaf(p1[4 * g4 + e], c2, ct2 - c1[e]); } }
            }
            {
            int ln2 = lane; asm volatile("" : "+v"(ln2));
            const LAS unsigned char* vbase = lds + 3 * KB + (tl & 1) * VB + (4 * (ln2 >> 5) + ((ln2 >> 2) & 3)) * VSTR + (16 * ((ln2 >> 4) & 1) + 4 * (ln2 & 3)) * 2;
            s16x4 fv[2][8];
#define ATT_LOADV(bf_, d0_) do { _Pragma("unroll") for (int s = 0; s < 4; ++s) { fv[bf_][2 * s] = vtr(vbase + (16 * s) * VSTR + (d0_) * 64); fv[bf_][2 * s + 1] = vtr(vbase + (16 * s + 8) * VSTR + (d0_) * 64); } } while (0)
            ATT_LOADV(0, 0); __builtin_amdgcn_sched_barrier(0);
            if (64 * j + 63 > qfirst) {
                const float NEG = -__builtin_inff();
                const int tq = qfirst + (ln2 & 31);
#pragma unroll
                for (int r = 0; r < 16; ++r) { const int key = 64 * j + crow(r, ln2 >> 5); if (key > tq) p0[r] = NEG; if (key + 32 > tq) p1[r] = NEG; }
            }
            float zmax = p0[0];
#pragma unroll
            for (int r = 1; r < 16; ++r) zmax = fmaxf(zmax, p0[r]);
#pragma unroll
            for (int r = 0; r < 16; ++r) zmax = fmaxf(zmax, p1[r]);
            zmax = fmaxf(zmax, __shfl_xor(zmax, 32));
            const float sc = FOX ? 1.0f : c2, zs = zmax * sc;
            const bool need = zs > m_run + 8.0f;
            const float alpha = need ? __builtin_amdgcn_exp2f(m_run - zs) : 1.0f; if (need) m_run = zs;
            const float nm = -m_run;
            float ps = 0.f;
#pragma unroll
            for (int r = 0; r < 16; ++r) { p0[r] = __builtin_amdgcn_exp2f(__builtin_fmaf(p0[r], sc, nm)); p1[r] = __builtin_amdgcn_exp2f(__builtin_fmaf(p1[r], sc, nm)); ps += p0[r] + p1[r]; }
            ps += __shfl_xor(ps, 32);
            l_run = l_run * alpha + ps;
            if (__any(need)) {
#pragma unroll
                for (int d0 = 0; d0 < 4; ++d0)
#pragma unroll
                    for (int r = 0; r < 16; ++r) o[d0][r] *= alpha; }
            bf16x8 pf[4]; pf[0] = packp8(p0, 0); pf[1] = packp8(p0, 1); pf[2] = packp8(p1, 0); pf[3] = packp8(p1, 1);
            __builtin_amdgcn_sched_barrier(0); ATT_LOADV(1, 1); __builtin_amdgcn_sched_barrier(0);
#pragma unroll
            for (int d0 = 0; d0 < 4; ++d0) {
#pragma unroll
                for (int s = 0; s < 4; ++s) o[d0] = MFMA32(cat44(fv[d0 & 1][2 * s], fv[d0 & 1][2 * s + 1]), pf[s], o[d0]);
                __builtin_amdgcn_sched_barrier(0);
                if (d0 + 2 < 4) { ATT_LOADV(d0 & 1, d0 + 2); __builtin_amdgcn_sched_barrier(0); } }
#undef ATT_LOADV
            }
        }
        ATT_WAITBAR(NKOPS);
    }
    asm volatile("s_waitcnt vmcnt(0)" ::: "memory");
#undef ATT_DMAK
#undef ATT_DMAV
#undef ATT_WAITBAR
    const float rl = 1.0f / l_run;
    bf16* orow = Op + ((size_t)b * SEQ + t) * opitch;
#pragma unroll
    for (int d0 = 0; d0 < 4; ++d0)
#pragma unroll
        for (int g4 = 0; g4 < 4; ++g4) { u32x2 wv; wv.x = pg8::cvt_pk_bf16(o[d0][4 * g4 + 0] * rl, o[d0][4 * g4 + 1] * rl); wv.y = pg8::cvt_pk_bf16(o[d0][4 * g4 + 2] * rl, o[d0][4 * g4 + 3] * rl);
            *(u32x2*)(orow + 32 * d0 + 8 * g4 + 4 * hi) = wv; }
    __syncthreads();
}

DEVI void ret_kv_unit(LAS unsigned char* lds, int bh, int c, const bf16* __restrict__ RK, const bf16* __restrict__ PROJ, float* __restrict__ KVC, float lg2) {
    constexpr int STR = 320;
    int tid_o = threadIdx.x; asm volatile("" : "+v"(tid_o));
    const int tid = tid_o, w = __builtin_amdgcn_readfirstlane(tid >> 6), lane = tid & 63, hi = lane >> 5;
    const int b = bh >> 3, h = bh & 7; const size_t m0 = (size_t)b * SEQ + (size_t)c * 128;
    LAS unsigned char* Kt = lds; LAS unsigned char* Vt = lds + 128 * STR;
    __syncthreads();
#pragma unroll
    for (int i = 0; i < 4; ++i) { const int ci = tid + 512 * i, row = ci >> 4, ch = ci & 15;
        const u32x4 kv = *(const u32x4*)(RK + (m0 + row) * 1024 + h * 128 + ch * 8); float f[8]; unpack8(kv, f); const float kd = __builtin_amdgcn_exp2f(lg2 * (float)(127 - row));
#pragma unroll
        for (int e = 0; e < 8; ++e) f[e] *= kd;
        *(LAS u32x4*)(Kt + row * STR + ch * 16) = pack8(f);
        *(LAS u32x4*)(Vt + row * STR + ch * 16) = *(const u32x4*)(PROJ + (m0 + row) * NINP + C_RV + h * 128 + ch * 8); }
    __syncthreads();
    const int eb = w & 3, dh = w >> 2, g = lane >> 4, q4 = (lane >> 2) & 3, p4 = lane & 3;
    const LAS unsigned char* abase = Vt + (4 * hi + q4) * STR + (32 * eb + 16 * (g & 1) + 4 * p4) * 2;
    const LAS unsigned char* bbase = Kt + (4 * hi + q4) * STR + (64 * dh + 16 * (g & 1) + 4 * p4) * 2;
    f32x16 acc[2];
#pragma unroll
    for (int r = 0; r < 16; ++r) { acc[0][r] = 0.f; acc[1][r] = 0.f; }
#pragma unroll
    for (int js = 0; js < 8; ++js) { const bf16x8 A = cat44(vtr(abase + (16 * js) * STR), vtr(abase + (16 * js + 8) * STR));
#pragma unroll
        for (int x = 0; x < 2; ++x) { const bf16x8 B = cat44(vtr(bbase + (16 * js) * STR + x * 64), vtr(bbase + (16 * js + 8) * STR + x * 64)); acc[x] = MFMA32(A, B, acc[x]); } }
    float* outp = KVC + ((size_t)(bh * 64 + c) * 128) * 128;
#pragma unroll
    for (int x = 0; x < 2; ++x)
#pragma unroll
        for (int r = 0; r < 16; ++r) outp[(size_t)(32 * eb + crow(r, hi)) * 128 + 64 * dh + 32 * x + (lane & 31)] = acc[x][r];
}

DEVI void ret_out_unit(LAS unsigned char* lds, int bh, int c, const bf16* __restrict__ RQ, const bf16* __restrict__ RK, const bf16* __restrict__ PROJ, const bf16* __restrict__ STB,
                       const float* __restrict__ gain, const float* __restrict__ bias, bf16* __restrict__ CAT, float lg2) {
    constexpr int KS = 272, VS = 320;
    int tid_o = threadIdx.x; asm volatile("" : "+v"(tid_o));
    const int tid = tid_o, w = __builtin_amdgcn_readfirstlane(tid >> 6), lane = tid & 63, r32 = lane & 31, hi = lane >> 5;
    const int b = bh >> 3, h = bh & 7; const size_t m0 = (size_t)b * SEQ + (size_t)c * 128;
    LAS unsigned char* Kt = lds; LAS unsigned char* Vt = lds + 128 * KS; LAS unsigned char* St = lds + 128 * KS + 128 * VS; LAS float* part = (LAS float*)(lds + 128 * KS + 128 * VS + 128 * KS);
    __syncthreads();
    const bf16* stsrc = STB + (size_t)(bh * 64 + c) * 16384;
#pragma unroll
    for (int i = 0; i < 4; ++i) { const int ci = tid + 512 * i, row = ci >> 4, ch = ci & 15;
        *(LAS u32x4*)(Kt + row * KS + ch * 16) = *(const u32x4*)(RK + (m0 + row) * 1024 + h * 128 + ch * 8);
        *(LAS u32x4*)(Vt + row * VS + ch * 16) = *(const u32x4*)(PROJ + (m0 + row) * NINP + C_RV + h * 128 + ch * 8);
        *(LAS u32x4*)(St + row * KS + ch * 16) = *(const u32x4*)(stsrc + row * 128 + ch * 8); }
    __syncthreads();
    const int ib = w & 3, eh = w >> 2, iloc = 32 * ib + r32; const size_t m = m0 + iloc;
    bf16x8 qf[8];
#pragma unroll
    for (int ds = 0; ds < 8; ++ds) qf[ds] = *(const bf16x8*)(RQ + m * 1024 + h * 128 + 16 * ds + 8 * hi);
    f32x16 o[2];
#pragma unroll
    for (int r = 0; r < 16; ++r) { o[0][r] = 0.f; o[1][r] = 0.f; }
    const int g = lane >> 4, q4 = (lane >> 2) & 3, p4 = lane & 3;
    const LAS unsigned char* vbase = Vt + (4 * hi + q4) * VS + (64 * eh + 16 * (g & 1) + 4 * p4) * 2;
    for (int jb = 0; jb <= ib; ++jb) {
        f32x16 p;
#pragma unroll
        for (int r = 0; r < 16; ++r) p[r] = 0.f;
        const LAS unsigned char* ka = Kt + (32 * jb + r32) * KS + hi * 16;
#pragma unroll
        for (int ds = 0; ds < 8; ++ds) p = MFMA32(*(const LAS bf16x8*)(ka + ds * 32), qf[ds], p);
#pragma unroll
        for (int r = 0; r < 16; ++r) { const int diff = iloc - (32 * jb + crow(r, hi)); p[r] = (diff >= 0) ? p[r] * __builtin_amdgcn_exp2f(lg2 * (float)diff) : 0.f; }
        const bf16x8 pf0 = packp8(p, 0), pf1 = packp8(p, 1);
        const LAS unsigned char* vb = vbase + (32 * jb) * VS;
#pragma unroll
        for (int x = 0; x < 2; ++x) {
            o[x] = MFMA32(cat44(vtr(vb + x * 64), vtr(vb + 8 * VS + x * 64)), pf0, o[x]);
            o[x] = MFMA32(cat44(vtr(vb + 16 * VS + x * 64), vtr(vb + 24 * VS + x * 64)), pf1, o[x]); }
    }
    {   f32x16 ca[2];
#pragma unroll
        for (int r = 0; r < 16; ++r) { ca[0][r] = 0.f; ca[1][r] = 0.f; }
        const LAS unsigned char* sa = St + (64 * eh + r32) * KS + hi * 16;
#pragma unroll
        for (int ds = 0; ds < 8; ++ds) { ca[0] = MFMA32(*(const LAS bf16x8*)(sa + ds * 32), qf[ds], ca[0]); ca[1] = MFMA32(*(const LAS bf16x8*)(sa + 32 * KS + ds * 32), qf[ds], ca[1]); }
        const float qd = __builtin_amdgcn_exp2f(lg2 * (float)(iloc + 1));
#pragma unroll
        for (int r = 0; r < 16; ++r) { o[0][r] += qd * ca[0][r]; o[1][r] += qd * ca[1][r]; } }
    float s1 = 0.f, s2 = 0.f;
#pragma unroll
    for (int r = 0; r < 16; ++r) { s1 += o[0][r] + o[1][r]; s2 += o[0][r] * o[0][r] + o[1][r] * o[1][r]; }
    s1 += __shfl_xor(s1, 32); s2 += __shfl_xor(s2, 32);
    if (hi == 0) { part[(eh * 128 + iloc) * 2] = s1; part[(eh * 128 + iloc) * 2 + 1] = s2; }
    __syncthreads();
    const float t1 = part[iloc * 2] + part[(128 + iloc) * 2], t2 = part[iloc * 2 + 1] + part[(128 + iloc) * 2 + 1];
    const float mu = t1 * (1.0f / 128.0f), var = fmaxf(t2 * (1.0f / 128.0f) - mu * mu, 0.f), rstd = 1.0f / sqrtf(var + LN_EPS);
    const bf16* grow = PROJ + m * NINP + C_RG + h * 128; bf16* orow = CAT + m * DM + h * 128;
#pragma unroll
    for (int x = 0; x < 2; ++x)
#pragma unroll
        for (int g4 = 0; g4 < 4; ++g4) { const int e0 = 64 * eh + 32 * x + 8 * g4 + 4 * hi;
            const f32x4 gn = *(const f32x4*)(gain + h * 128 + e0), bs = *(const f32x4*)(bias + h * 128 + e0); const u32x2 gw = *(const u32x2*)(grow + e0);
            const float gg[4] = {__uint_as_float(gw.x << 16), __uint_as_float(gw.x & 0xffff0000u), __uint_as_float(gw.y << 16), __uint_as_float(gw.y & 0xffff0000u)};
            float y[4];
#pragma unroll
            for (int e = 0; e < 4; ++e) y[e] = ((o[x][4 * g4 + e] - mu) * rstd * gn[e] + bs[e]) * (gg[e] * sigm(gg[e]));
            u32x2 wv; wv.x = pg8::cvt_pk_bf16(y[0], y[1]); wv.y = pg8::cvt_pk_bf16(y[2], y[3]); *(u32x2*)(orow + e0) = wv; }
}

struct Args { const void* in[35]; float* out; unsigned char* ws; int ph_lo, ph_hi; };
constexpr int NPH_LAYER = 16, NPHASES = 1 + DEPTH * NPH_LAYER;

__global__ void __launch_bounds__(NTHR, 2) fwd_kernel(Args args) {
    extern __shared__ __attribute__((aligned(16))) unsigned char lds_raw[];
    LAS unsigned char* lds = (LAS unsigned char*)lds_raw;
    const int G = gridDim.x, bid = blockIdx.x, NGW = G * NWAVES;
#define PHASE_IDS() int tid = threadIdx.x; asm volatile("" : "+v"(tid)); const int lane = tid & 63, wave = __builtin_amdgcn_readfirstlane(tid >> 6), gw = bid * NWAVES + wave; (void)lane; (void)gw
    volatile LAS unsigned* MISC = (volatile LAS unsigned*)(lds + LDSCTL_OFF);
    volatile LAS unsigned long long* TAB = (volatile LAS unsigned long long*)(lds + LDSCTL_OFF + 1024);
    { PHASE_IDS();
      for (int u = tid; u < (LDS_BYTES - LDSCTL_OFF) / 4; u += NTHR) ((LAS unsigned*)(lds + LDSCTL_OFF))[u] = 0u;
      __syncthreads();
      if (tid == 0) {
#define TSET(i) TAB[i] = (unsigned long long)args.in[i];
        TSET(0) TSET(1) TSET(2) TSET(3) TSET(4) TSET(5) TSET(6) TSET(7) TSET(8) TSET(9) TSET(10) TSET(11) TSET(12) TSET(13) TSET(14) TSET(15) TSET(16) TSET(17)
        TSET(18) TSET(19) TSET(20) TSET(21) TSET(22) TSET(23) TSET(24) TSET(25) TSET(26) TSET(27) TSET(28) TSET(29) TSET(30) TSET(31) TSET(32) TSET(33) TSET(34)
#undef TSET
        TAB[35] = (unsigned long long)args.out; TAB[36] = (unsigned long long)args.ws; }
      __syncthreads(); }
#define INP(i) ((const float*)rfl64(TAB[i]))
#define WSP(T, off) ((T*)((unsigned char*)rfl64(TAB[36]) + (off)))
#define HBUF() ((float*)rfl64(TAB[35]))
    XcdBarrier bar; bar.bar = (unsigned*)WSP(unsigned, WS_CTL + CW_BAR * 4); bar.x = 0; bar.st = nullptr;
    if (!MK_SPLIT) bar = xcd_barrier_post((unsigned*)WSP(unsigned, WS_CTL + CW_BAR * 4), MISC + 8);
    const int lo = args.ph_lo, hi_ph = args.ph_hi;
#define IN(k) (lo <= (k) && (k) < hi_ph)
#ifndef MK_MASK
#define MK_MASK 0xffff
#endif
#define EN(b) ((MK_MASK >> (b)) & 1)
#ifndef MK_DUP
#define MK_DUP 0
#endif
#define DUP(b) ((MK_DUP >> (b)) & 1)
#define SEAM(k) do { if (IN(k) && IN((k) + 1)) xcd_barrier(bar); } while (0)

    if (EN(0) && IN(0)) { PHASE_IDS();
        const int gt = bid * NTHR + tid, NGT = G * NTHR;
        const float* x = INP(0); const float* p_in = INP(1); const int* positions = (const int*)INP(2); float* hbuf = HBUF();
        float* COS128 = WSP(float, WS_COS128); float* SIN128 = WSP(float, WS_SIN128); float* COS64 = WSP(float, WS_COS64); float* SIN64 = WSP(float, WS_SIN64); bf16* P16 = WSP(bf16, WS_P16); float* RS = WSP(float, WS_RS);
        for (int idx = gt; idx < M * 64; idx += NGT) { const int m = idx >> 6, i = idx & 63; float s, c; sincos_d((float)positions[m] * inv_freq(i, 0.8659643233600653), s, c); COS128[idx] = c; SIN128[idx] = s; }
        for (int idx = gt; idx < M * 32; idx += NGT) { const int m = idx >> 5, i = idx & 31; float s, c; sincos_d((float)positions[m] * inv_freq(i, 0.7498942093324559), s, c); COS64[idx] = c; SIN64[idx] = s; }
        for (int idx = gt; idx < DEPTH * M * 256 / 4; idx += 4 * NGT) { f32x4 v[4];
#pragma unroll
            for (int u = 0; u < 4; ++u) v[u] = (idx + u * NGT < DEPTH * M * 256 / 4) ? ((const f32x4*)p_in)[idx + u * NGT] : (f32x4){0.f, 0.f, 0.f, 0.f};
#pragma unroll
            for (int u = 0; u < 4; ++u) if (idx + u * NGT < DEPTH * M * 256 / 4) { u32x2 o; o.x = pk2(v[u].x, v[u].y); o.y = pk2(v[u].z, v[u].w); ((u32x2*)P16)[idx + u * NGT] = o; } }
        const float* g0 = INP(3);
        bf16* H16 = WSP(bf16, WS_H16);
        for (int m = gw; m < M; m += NGW) norm_row<true, false, true>(x + (size_t)m * DM, H16 + (size_t)m * DM, nullptr, 0.f, g0, RS + m, lane);
    }

    for (int L = 0; L < DEPTH; ++L) {
        const int pb = 1 + L * NPH_LAYER;
        for (int rep_ = 0; rep_ < (DUP(1) ? 2 : 1); ++rep_) if (EN(1) && IN(pb + 0)) { PHASE_IDS();
            LAS float* scr = (LAS float*)(lds + wave * 16384);
            bf16* W_GU1 = WSP(bf16, WS_WGU1); bf16* W_GU2 = WSP(bf16, WS_WGU2); bf16* W_D1 = WSP(bf16, WS_WD1); bf16* W_D2 = WSP(bf16, WS_WD2); bf16* W_IN = WSP(bf16, WS_WIN); bf16* W_OUT = WSP(bf16, WS_WOUT);
            bf16* W_PG = WSP(bf16, WS_WPG); bf16* W_PP = WSP(bf16, WS_WPP); bf16* W_UQ = WSP(bf16, WS_WUQ); bf16* W_UKV = WSP(bf16, WS_WUKV); bf16* W_PW = WSP(bf16, WS_WPW);
            constexpr int I_F = 22016, I_IN = 64 * 344, I_SQ = 64 * 128, I_PP = 4 * 128, I_UQ = 16 * 48, I_UKV = 8 * 64, I_PW = 16 * 32;
            constexpr int NITEMS = 6 * I_F + I_IN + 2 * I_SQ + I_PP + I_UQ + I_UKV + I_PW;
            const size_t oF = (size_t)L * DM * DFF;
            for (int it = gw; it < NITEMS; it += NGW) {
                int r = it;
                if (r < 6 * I_F) { const int seg = r / I_F; r -= seg * I_F; const int f = seg / 3, kind = seg % 3;
                    const float* Wsrc = (const float*)(f ? (kind == 0 ? INP(27) : kind == 1 ? INP(28) : INP(29)) : (kind == 0 ? INP(4) : kind == 1 ? INP(5) : INP(6))) + oF;
                    if (kind < 2) { const int kb = r / 344, nb = r % 344, n0 = nb * 32; tr_item(Wsrc, DM, DFF, (f ? W_GU2 : W_GU1), (n0 >> 7) * 256 + (n0 & 127) + kind * 128, scr, kb * 64, n0, lane, (const float*)(f ? INP(26) : INP(3)) + (size_t)L * DM); }
                    else { const int kb = r / 128, nb = r % 128; tr_item(Wsrc, DFF, DM, (f ? W_D2 : W_D1), nb * 32, scr, kb * 64, nb * 32, lane); }
                    continue; }
                r -= 6 * I_F;
                if (r < I_IN) { const int kb = r / 344, nb = r % 344; tr_item(INP(9) + (size_t)L * DM * NIN, DM, NIN, W_IN, nb * 32, scr, kb * 64, nb * 32, lane, INP(8) + (size_t)L * DM); continue; } r -= I_IN;
                if (r < I_SQ) { const int kb = r / 128, nb = r % 128; tr_item(INP(24) + (size_t)L * DM * DM, DM, DM, W_OUT, nb * 32, scr, kb * 64, nb * 32, lane); continue; } r -= I_SQ;
                if (r < I_SQ) { const int kb = r / 128, nb = r % 128; tr_item(INP(32) + (size_t)L * DM * DM, DM, DM, W_PG, nb * 32, scr, kb * 64, nb * 32, lane, INP(31) + (size_t)L * DM); continue; } r -= I_SQ;
                if (r < I_PP) { const int kb = r / 128, nb = r % 128; tr_item(INP(33) + (size_t)L * 256 * DM, 256, DM, W_PP, nb * 32, scr, kb * 64, nb * 32, lane); continue; } r -= I_PP;
                if (r < I_UQ) { const int kb = r / 48, nb = r % 48; tr_item(INP(11) + (size_t)L * 1024 * 1536, 1024, 1536, W_UQ, nb * 32, scr, kb * 64, nb * 32, lane); continue; } r -= I_UQ;
                if (r < I_UKV) { const int kb = r / 64, nb = r % 64; tr_item(INP(13) + (size_t)L * 512 * 2048, 512, 2048, W_UKV, nb * 32, scr, kb * 64, nb * 32, lane); continue; } r -= I_UKV;
                { const int kb = r / 32, nb = r % 32; tr_item(INP(22) + (size_t)L * 1024 * 1024, 1024, 1024, W_PW, nb * 32, scr, kb * 64, nb * 32, lane); }
            }
        }
        SEAM(pb + 0);

        for (int half = 0; half < 2; ++half) {
            const int fa = pb + (half ? 11 : 1);
            for (int rep_ = 0; rep_ < (DUP(2) ? 2 : 1); ++rep_) if (EN(2) && IN(fa)) { PHASE_IDS(); pg8::Gemm g{WSP(bf16, WS_H16), half ? WSP(bf16, WS_WGU2) : WSP(bf16, WS_WGU1), M, 2 * DFF, DM}; pg8::StaticOrder S; S.init(M, 2 * DFF, G, bid, 8); pg8::EpiSwiglu E{WSP(bf16, WS_ACT), DFF, WSP(float, WS_RS)};
                pg8::gemm_phase<pg8::EpiSwiglu, pg8::StaticOrder, true, true>(lds, g, S, E);
                if (half == 0) { const int nshort = (5504 % G) ? G - (5504 % G) : G; const int first = G - nshort;
                    if (bid >= first) { pg8::Gemm g2{WSP(bf16, WS_P16) + (size_t)L * M * 256, WSP(bf16, WS_WPP), M, DM, 256}; pg8::StaticOrder S2; S2.init(M, DM, nshort, bid - first); pg8::EpiBf16P E2{WSP(bf16, WS_PPB), DM, nullptr, nullptr};
                        pg8::gemm_phase<pg8::EpiBf16P, pg8::StaticOrder, true, true>(lds, g2, S2, E2); } } }
            SEAM(fa);
            for (int rep_ = 0; rep_ < (DUP(3) ? 2 : 1); ++rep_) if (EN(3) && IN(fa + 1)) { PHASE_IDS(); pg8::Gemm g{WSP(bf16, WS_ACT), half ? WSP(bf16, WS_WD2) : WSP(bf16, WS_WD1), M, DM, DFF}; pg8::StaticOrder S; S.init(M, DM, G, bid); pg8::EpiBf16P E{WSP(bf16, WS_Y), DM, nullptr, nullptr};
                pg8::gemm_phase<pg8::EpiBf16P, pg8::StaticOrder, true, true>(lds, g, S, E); }
            SEAM(fa + 1);
            for (int rep_ = 0; rep_ < (DUP(4) ? 2 : 1); ++rep_) if (EN(4) && IN(fa + 2)) { PHASE_IDS(); float* hbuf = HBUF(); const bf16* Y = WSP(bf16, WS_Y); float* RS = WSP(float, WS_RS);
                const float* gpost = (const float*)(half ? INP(30) : INP(7)) + (size_t)L * DM; const float* gpre = (const float*)(half ? INP(31) : INP(8)) + (size_t)L * DM;
                bf16* H16 = WSP(bf16, WS_H16);
                for (int m = gw; m < M; m += NGW) norm_row<false, false, true>(H16 + (size_t)m * DM, H16 + (size_t)m * DM, Y + (size_t)m * DM, rep_ ? 0.f : 0.5f, gpost, RS + m, lane);
            }
            SEAM(fa + 2);

            if (half == 0) {
                for (int rep_ = 0; rep_ < (DUP(5) ? 2 : 1); ++rep_) if (EN(5) && IN(pb + 4)) { PHASE_IDS(); pg8::Gemm g{WSP(bf16, WS_H16), WSP(bf16, WS_WIN), M, NINP, DM}; pg8::StaticOrder S; S.init(M, NINP, G, bid); pg8::EpiBf16P E{WSP(bf16, WS_ACT), NINP, nullptr, WSP(float, WS_RS)};
                    pg8::gemm_phase<pg8::EpiBf16P, pg8::StaticOrder, true, true>(lds, g, S, E); }
                SEAM(pb + 4);
                for (int rep_ = 0; rep_ < (DUP(6) ? 2 : 1); ++rep_) if (EN(6) && IN(pb + 5)) { PHASE_IDS();
                    const bf16* PROJ = WSP(bf16, WS_ACT); const float* COS128 = WSP(float, WS_COS128); const float* SIN128 = WSP(float, WS_SIN128); const float* COS64 = WSP(float, WS_COS64); const float* SIN64 = WSP(float, WS_SIN64);
                    bf16* RQ = WSP(bf16, WS_RQ); bf16* RK = WSP(bf16, WS_RK); bf16* CQN = WSP(bf16, WS_CQN); bf16* CKVN = WSP(bf16, WS_CKVN); bf16* KR = WSP(bf16, WS_KR); float* LOGF = WSP(float, WS_LOGF); bf16* U = WSP(bf16, WS_U);
                    const float* qn = INP(10) + L * 1024; const float* kvn = INP(12) + L * 512; const float* fb = INP(16) + L * 8; const float* gb = INP(17) + L * 2048;
                    float mq0 = 0.f, mq1 = 0.f, mk0 = 0.f, mk1 = 0.f;
                    float qn0[8], qn1[8], kvn0[8], gba[2][8], gbg[2][8];
#pragma unroll
                    for (int e = 0; e < 8; ++e) { qn0[e] = qn[lane * 8 + e]; qn1[e] = qn[512 + lane * 8 + e]; kvn0[e] = kvn[lane * 8 + e];
                        gba[0][e] = gb[lane * 8 + e]; gba[1][e] = gb[512 + lane * 8 + e]; gbg[0][e] = gb[1024 + lane * 8 + e]; gbg[1][e] = gb[1536 + lane * 8 + e]; }
                    for (int m = gw; m < M; m += NGW) {
                        const bf16* pr = PROJ + (size_t)m * NINP; const int b = m >> 13, t = m & (SEQ - 1);
                        const int l16 = lane & 15, hq = lane >> 4;
                        u32x2 qa[2], qb[2], ka[2], kb[2];
#pragma unroll
                        for (int g = 0; g < 2; ++g) { const int ho = (4 * g + hq) * 128 + 4 * l16;
                            qa[g] = *(const u32x2*)(pr + C_RQ + ho); qb[g] = *(const u32x2*)(pr + C_RQ + ho + 64); ka[g] = *(const u32x2*)(pr + C_RK + ho); kb[g] = *(const u32x2*)(pr + C_RK + ho + 64); }
                        const f32x4 c4 = *(const f32x4*)(COS128 + m * 64 + 4 * l16), s4 = *(const f32x4*)(SIN128 + m * 64 + 4 * l16);
                        const u32x4 cq0 = *(const u32x4*)(pr + C_CQ + lane * 8), cq1 = *(const u32x4*)(pr + C_CQ + 512 + lane * 8), ckv = *(const u32x4*)(pr + C_CKV + lane * 8);
                        const u32x4 fq0 = *(const u32x4*)(pr + C_FQ + lane * 16), fq1 = *(const u32x4*)(pr + C_FQ + lane * 16 + 8), fk0 = *(const u32x4*)(pr + C_FK + lane * 16), fk1 = *(const u32x4*)(pr + C_FK + lane * 16 + 8);
                        const u32x4 ca0 = *(const u32x4*)(pr + C_CIN + lane * 8), ca1 = *(const u32x4*)(pr + C_CIN + 512 + lane * 8), cg0 = *(const u32x4*)(pr + C_CIN + 1024 + lane * 8), cg1 = *(const u32x4*)(pr + C_CIN + 1536 + lane * 8);
                        float c64 = 0.f, s64 = 0.f; unsigned short kr1 = 0, kr2 = 0, ffr = 0;
                        if (lane < 32) { c64 = COS64[m * 32 + lane]; s64 = SIN64[m * 32 + lane]; kr1 = pr[C_KR + lane]; kr2 = pr[C_KR + 32 + lane]; }
                        if (lane < 8) ffr = pr[C_FF + lane];
                        {
#pragma unroll
                          for (int g = 0; g < 2; ++g) { const size_t oo = (size_t)m * 1024 + (4 * g + hq) * 128 + 4 * l16;
                              const f32x4 q1 = {__uint_as_float(qa[g].x << 16), __uint_as_float(qa[g].x & 0xffff0000u), __uint_as_float(qa[g].y << 16), __uint_as_float(qa[g].y & 0xffff0000u)};
                              const f32x4 q2 = {__uint_as_float(qb[g].x << 16), __uint_as_float(qb[g].x & 0xffff0000u), __uint_as_float(qb[g].y << 16), __uint_as_float(qb[g].y & 0xffff0000u)};
                              const f32x4 k1 = {__uint_as_float(ka[g].x << 16), __uint_as_float(ka[g].x & 0xffff0000u), __uint_as_float(ka[g].y << 16), __uint_as_float(ka[g].y & 0xffff0000u)};
                              const f32x4 k2 = {__uint_as_float(kb[g].x << 16), __uint_as_float(kb[g].x & 0xffff0000u), __uint_as_float(kb[g].y << 16), __uint_as_float(kb[g].y & 0xffff0000u)};
                              const f32x4 qo1 = q1 * c4 - q2 * s4, qo2 = q2 * c4 + q1 * s4, ko1 = (k1 * c4 - k2 * s4) * 0.08838834764831845f, ko2 = (k2 * c4 + k1 * s4) * 0.08838834764831845f;
                              u32x2 w; w.x = pk2(qo1.x, qo1.y); w.y = pk2(qo1.z, qo1.w); *(u32x2*)(RQ + oo) = w; w.x = pk2(qo2.x, qo2.y); w.y = pk2(qo2.z, qo2.w); *(u32x2*)(RQ + oo + 64) = w;
                              w.x = pk2(ko1.x, ko1.y); w.y = pk2(ko1.z, ko1.w); *(u32x2*)(RK + oo) = w; w.x = pk2(ko2.x, ko2.y); w.y = pk2(ko2.z, ko2.w); *(u32x2*)(RK + oo + 64) = w; } }
                        { float f0[8], f1[8]; unpack8(cq0, f0); unpack8(cq1, f1); float ss = 0.f;
#pragma unroll
                          for (int e = 0; e < 8; ++e) ss += f0[e] * f0[e] + f1[e] * f1[e];
                          const float rs = 1.0f / sqrtf(wave_sum(ss) * (1.0f / 1024.0f) + NORM_EPS);
#pragma unroll
                          for (int e = 0; e < 8; ++e) { f0[e] *= rs * qn0[e]; f1[e] *= rs * qn1[e]; }
                          *(u32x4*)(CQN + (size_t)m * 1024 + lane * 8) = pack8(f0); *(u32x4*)(CQN + (size_t)m * 1024 + 512 + lane * 8) = pack8(f1); }
                        { float f0[8]; unpack8(ckv, f0); float ss = 0.f;
#pragma unroll
                          for (int e = 0; e < 8; ++e) ss += f0[e] * f0[e];
                          const float rs = 1.0f / sqrtf(wave_sum(ss) * (1.0f / 512.0f) + NORM_EPS);
#pragma unroll
                          for (int e = 0; e < 8; ++e) f0[e] *= rs * kvn0[e];
                          *(u32x4*)(CKVN + (size_t)m * 512 + lane * 8) = pack8(f0); }
                        if (lane < 32) { const float x1 = bf2f(kr1), x2 = bf2f(kr2);
                            KR[(size_t)m * 64 + lane] = (bf16)f2bf(x1 * c64 - x2 * s64); KR[(size_t)m * 64 + 32 + lane] = (bf16)f2bf(x2 * c64 + x1 * s64); }
                        { float fq[8], fk[8]; float sq = 0.f, sk = 0.f;
                          unpack8(fq0, fq); unpack8(fk0, fk);
#pragma unroll
                          for (int e = 0; e < 8; ++e) { sq += fq[e] * fq[e]; sk += fk[e] * fk[e]; }
                          unpack8(fq1, fq); unpack8(fk1, fk);
#pragma unroll
                          for (int e = 0; e < 8; ++e) { sq += fq[e] * fq[e]; sk += fk[e] * fk[e]; }
                          sq += __shfl_xor(sq, 1); sq += __shfl_xor(sq, 2); sq += __shfl_xor(sq, 4); sk += __shfl_xor(sk, 1); sk += __shfl_xor(sk, 2); sk += __shfl_xor(sk, 4);
                          if (b) { mq1 = fmaxf(mq1, sq); mk1 = fmaxf(mk1, sk); } else { mq0 = fmaxf(mq0, sq); mk0 = fmaxf(mk0, sk); } }
                        if (lane < 8) { const float xv = bf2f(ffr) + fb[lane]; LOGF[(size_t)(b * 8 + lane) * SEQ + t] = fminf(xv, 0.f) - __logf(1.0f + __expf(-fabsf(xv))); }
                        {
#pragma unroll
                          for (int hf = 0; hf < 2; ++hf) { const int c0 = hf * 512 + lane * 8; float a[8], gt_[8]; unpack8(hf ? ca1 : ca0, a); unpack8(hf ? cg1 : cg0, gt_);
#pragma unroll
                              for (int e = 0; e < 8; ++e) a[e] = (a[e] + gba[hf][e]) * sigm(gt_[e] + gbg[hf][e]);
                              *(u32x4*)(U + (size_t)m * 1024 + c0) = pack8(a); } }
                    }
                    {
                        LAS float* part = (LAS float*)lds;
                        if ((lane & 7) == 0) { const int h = lane >> 3; LAS float* pw = part + wave * 32; pw[(0 * 8 + h) * 2] = mq0; pw[(0 * 8 + h) * 2 + 1] = mk0; pw[(1 * 8 + h) * 2] = mq1; pw[(1 * 8 + h) * 2 + 1] = mk1; }
                        __syncthreads();
                        if (tid < 32) { float v = part[tid];
#pragma unroll
                            for (int ww = 1; ww < 8; ++ww) v = fmaxf(v, part[ww * 32 + tid]);
                            WSP(float, WS_CTL + CW_QK * 4)[(size_t)L * 32768 + bid * 32 + tid] = v; }
                        __syncthreads(); }
                }
                SEAM(pb + 5);
                for (int rep_ = 0; rep_ < (DUP(7) ? 2 : 1); ++rep_) if (EN(7) && IN(pb + 6)) { PHASE_IDS();
                    const float* LOGF = WSP(float, WS_LOGF); float* CUM2 = WSP(float, WS_CUM2);
                    if (bid < 16) {
                        LAS double* sc = (LAS double*)lds;
                        const float* src = LOGF + (size_t)bid * SEQ + tid * 16; float v[16];
#pragma unroll
                        for (int e = 0; e < 4; ++e) { const f32x4 q = ((const f32x4*)src)[e]; v[4 * e] = q.x; v[4 * e + 1] = q.y; v[4 * e + 2] = q.z; v[4 * e + 3] = q.w; }
                        double tot = 0.0;
#pragma unroll
                        for (int e = 0; e < 16; ++e) tot += (double)v[e];
                        double inc = tot;
#pragma unroll
                        for (int o = 1; o < 64; o <<= 1) { const double nb = __shfl_up(inc, o); if (lane >= o) inc += nb; }
                        if (lane == 63) sc[wave] = inc;
                        __syncthreads();
                        double base = inc - tot;
                        for (int ww = 0; ww < wave; ++ww) base += sc[ww];
                        float* dst = CUM2 + (size_t)bid * SEQ + tid * 16;
#pragma unroll
                        for (int e = 0; e < 16; ++e) { base += (double)v[e]; dst[e] = (float)(base * 1.4426950408889634074); }
                        __syncthreads();
                    }
                    { pg8::Gemm g{WSP(bf16, WS_CQN), WSP(bf16, WS_WUQ), M, 1536, 1024}; pg8::StaticOrder S; S.init(M, 1536, G, bid); pg8::EpiBf16P E{WSP(bf16, WS_MQ), 1536, nullptr, nullptr};
                      pg8::gemm_phase<pg8::EpiBf16P, pg8::StaticOrder, true, true>(lds, g, S, E); }
                    { pg8::Gemm g{WSP(bf16, WS_CKVN), WSP(bf16, WS_WUKV), M, 2048, 512}; pg8::StaticOrder S; S.init(M, 2048, G, bid); pg8::EpiBf16P E{WSP(bf16, WS_KVR), 2048, nullptr, nullptr};
                      pg8::gemm_phase<pg8::EpiBf16P, pg8::StaticOrder, true, true>(lds, g, S, E); }
                    {
                        const bf16* U = WSP(bf16, WS_U); bf16* YC = WSP(bf16, WS_YC);
                        const float* dw = INP(18) + (size_t)L * 31 * 1024; const float* dwb = INP(19) + L * 1024;
                        const float* lng = INP(20) + L * 1024; const float* lnb = INP(21) + L * 1024;
                        for (int grp = gw; grp < M / 4; grp += NGW) { const int m0 = grp * 4, t0 = m0 & (SEQ - 1);
                            float acc[4][16]; f32x4 wt[4][4];
#pragma unroll
                            for (int o = 0; o < 4; ++o)
#pragma unroll
                                for (int e = 0; e < 16; ++e) acc[o][e] = 0.f;
#pragma unroll
                            for (int s = 0; s < 4; ++s)
#pragma unroll
                                for (int q = 0; q < 4; ++q) wt[s][q] = (f32x4){0.f, 0.f, 0.f, 0.f};
#pragma unroll 1
                            for (int qq = 0; qq < 9; ++qq) {
#pragma unroll
                                for (int s = 0; s < 4; ++s) { const int ri = 4 * qq + s;
                                    if (s & 1) asm volatile("" ::: "memory");
                                    if (ri <= 33) {
                                        if (ri <= 30) {
#pragma unroll
                                            for (int hf = 0; hf < 2; ++hf) { wt[s][2 * hf] = *(const f32x4*)(dw + ri * 1024 + hf * 512 + lane * 8); wt[s][2 * hf + 1] = *(const f32x4*)(dw + ri * 1024 + hf * 512 + lane * 8 + 4); } }
                                        const int tt = t0 - 30 + ri;
                                        if (tt >= 0) { float ua[8], ub[8]; const bf16* ur = U + (size_t)(m0 - 30 + ri) * 1024;
                                            unpack8(*(const u32x4*)(ur + lane * 8), ua); unpack8(*(const u32x4*)(ur + 512 + lane * 8), ub);
#pragma unroll
                                            for (int o = 0; o < 4; ++o) { const int j = ri - o;
                                                if (j >= 0 && j <= 30) { const int ws = (s - o) & 3;
#pragma unroll
                                                    for (int e = 0; e < 4; ++e) { acc[o][e] += ua[e] * wt[ws][0][e]; acc[o][4 + e] += ua[4 + e] * wt[ws][1][e]; acc[o][8 + e] += ub[e] * wt[ws][2][e]; acc[o][12 + e] += ub[4 + e] * wt[ws][3][e]; } } } } } } }
#pragma unroll
                            for (int o = 0; o < 4; ++o) { const int m = m0 + o; float s1 = 0.f;
#pragma unroll
                                for (int hf = 0; hf < 2; ++hf)
#pragma unroll
                                    for (int e = 0; e < 8; ++e) { acc[o][hf * 8 + e] += dwb[hf * 512 + lane * 8 + e]; s1 += acc[o][hf * 8 + e]; }
                                const float mu = wave_sum(s1) * (1.0f / 1024.0f); float s2 = 0.f;
#pragma unroll
                                for (int e = 0; e < 16; ++e) { acc[o][e] -= mu; s2 += acc[o][e] * acc[o][e]; }
                                const float rstd = 1.0f / sqrtf(wave_sum(s2) * (1.0f / 1024.0f) + LN_EPS);
#pragma unroll
                                for (int hf = 0; hf < 2; ++hf) { const int c0 = hf * 512 + lane * 8; float o8[8];
#pragma unroll
                                    for (int e = 0; e < 8; ++e) { const float yv = acc[o][hf * 8 + e] * rstd * lng[c0 + e] + lnb[c0 + e]; o8[e] = yv * sigm(yv); }
                                    *(u32x4*)(YC + (size_t)m * 1024 + c0) = pack8(o8); } } }
                    }
                    asm volatile("s_waitcnt vmcnt(0)" ::: "memory");
                    { const bf16* RK = WSP(bf16, WS_RK); const bf16* PROJ = WSP(bf16, WS_ACT); float* KVC = WSP(float, WS_KVC);
                      for (int u = bid; u < 1024; u += G) { const int bh = u >> 6, c = u & 63; ret_kv_unit(lds, bh, c, RK, PROJ, KVC, ret_lg2(bh & 7)); } }
                    __syncthreads();
                }
                SEAM(pb + 6);
                if (EN(8) && IN(pb + 7)) { PHASE_IDS();
                    { pg8::Gemm g{WSP(bf16, WS_YC), WSP(bf16, WS_WPW), M, 1024, 1024}; pg8::StaticOrder S; S.init(M, 1024, G, bid); pg8::EpiBf16P E{WSP(bf16, WS_CAT) + 3072, DM, INP(23) + L * 1024, nullptr};
                      pg8::gemm_phase<pg8::EpiBf16P, pg8::StaticOrder, true, true>(lds, g, S, E); }
                    bf16* MQ = WSP(bf16, WS_MQ); const float* COS64 = WSP(float, WS_COS64); const float* SIN64 = WSP(float, WS_SIN64); const float* KVC = WSP(float, WS_KVC); bf16* STB = WSP(bf16, WS_ST);
                    for (int m = gw; m < M; m += NGW) { const int hh = lane >> 3, i4 = (lane & 7) * 4; bf16* qp = MQ + (size_t)m * 1536 + hh * 192 + 128 + i4;
                        const u32x2 xa = *(const u32x2*)qp, xb = *(const u32x2*)(qp + 32); const f32x4 cc = *(const f32x4*)(COS64 + m * 32 + i4), sn = *(const f32x4*)(SIN64 + m * 32 + i4);
                        const f32x4 x1 = {__uint_as_float(xa.x << 16), __uint_as_float(xa.x & 0xffff0000u), __uint_as_float(xa.y << 16), __uint_as_float(xa.y & 0xffff0000u)};
                        const f32x4 x2 = {__uint_as_float(xb.x << 16), __uint_as_float(xb.x & 0xffff0000u), __uint_as_float(xb.y << 16), __uint_as_float(xb.y & 0xffff0000u)};
                        const f32x4 o1 = x1 * cc - x2 * sn, o2 = x2 * cc + x1 * sn;
                        u32x2 w; w.x = pk2(o1.x, o1.y); w.y = pk2(o1.z, o1.w); *(u32x2*)qp = w; w.x = pk2(o2.x, o2.y); w.y = pk2(o2.z, o2.w); *(u32x2*)(qp + 32) = w; }
                    for (int idx = bid * NTHR + tid; idx < 16 * 8192; idx += G * NTHR) { const int bh = idx >> 13, ed = (idx & 8191) * 2; const float cd = __builtin_amdgcn_exp2f(ret_lg2(bh & 7) * 128.0f);
                        const float* kp = KVC + (size_t)bh * 64 * 16384 + ed; bf16* sp = STB + (size_t)bh * 64 * 16384 + ed; float S0 = 0.f, S1 = 0.f;
                        for (int cb = 0; cb < 64; cb += 16) { float kv0[16], kv1[16];
#pragma unroll
                            for (int c = 0; c < 16; ++c) { kv0[c] = kp[(size_t)(cb + c) * 16384]; kv1[c] = kp[(size_t)(cb + c) * 16384 + 1]; }
#pragma unroll
                            for (int c = 0; c < 16; ++c) { *(unsigned*)(sp + (size_t)(cb + c) * 16384) = pk2(S0, S1); S0 = S0 * cd + kv0[c]; S1 = S1 * cd + kv1[c]; } } }
                }
                SEAM(pb + 7);
                for (int rep_ = 0; rep_ < (DUP(9) ? 2 : 1); ++rep_) if (EN(9) && IN(pb + 8)) { PHASE_IDS();
                    asm volatile("s_waitcnt vmcnt(0)" ::: "memory"); __syncthreads();
                    const bf16* MQ = WSP(bf16, WS_MQ); const bf16* KVR = WSP(bf16, WS_KVR); const bf16* KR = WSP(bf16, WS_KR); const bf16* PROJ = WSP(bf16, WS_ACT); const float* CUM2 = WSP(float, WS_CUM2); bf16* CAT = WSP(bf16, WS_CAT);
                    const bf16* RQ = WSP(bf16, WS_RQ); const bf16* RK = WSP(bf16, WS_RK); const bf16* STB = WSP(bf16, WS_ST); const float* QKP = WSP(float, WS_CTL + CW_QK * 4) + (size_t)L * 32768;
                    for (int k = bid; k < 512; k += G) { const int i = (k < 256) ? k : 767 - k; const int qb = 31 - (i >> 4), bh = i & 15, b = bh >> 3, h = bh & 7;
                        attn_unit<192, false>(lds, b, qb, MQ + h * 192, 1536, KVR + h * 256, 2048, KR, 64, KVR + h * 256 + 128, 2048, nullptr, CAT + 1024 + h * 128, DM, 0.07216878364870323f * LOG2E, 0.f); }
                    for (int k = bid; k < 512; k += G) { const int i = (k < 256) ? k : 767 - k; const int qb = 31 - (i >> 4), bh = i & 15, b = bh >> 3, h = bh & 7;
                        float mq = 0.f, mk = 0.f; int ln_ = threadIdx.x; asm volatile("" : "+v"(ln_)); for (int blk = ln_ & 63; blk < G; blk += 64) { mq = fmaxf(mq, QKP[blk * 32 + bh * 2]); mk = fmaxf(mk, QKP[blk * 32 + bh * 2 + 1]); }
                        mq = wave_max(mq); mk = wave_max(mk);
                        const float qkm = sqrtf(mq * mk) * (0.08838834764831845f * LOG2E);
                        attn_unit<128, true>(lds, b, qb, PROJ + C_FQ + h * 128, NINP, PROJ + C_FK + h * 128, NINP, nullptr, 0, PROJ + C_FV + h * 128, NINP, CUM2 + (size_t)bh * SEQ, CAT + 2048 + h * 128, DM, 0.08838834764831845f * LOG2E, qkm); }
                    const float* gg = INP(14) + L * 1024; const float* gbias = INP(15) + L * 1024;
                    for (int u = bid; u < 1024; u += G) { const int bh = u >> 6, c = u & 63; ret_out_unit(lds, bh, c, RQ, RK, PROJ, STB, gg, gbias, CAT, ret_lg2(bh & 7)); }
                    __syncthreads();
                }
                SEAM(pb + 8);
                for (int rep_ = 0; rep_ < (DUP(10) ? 2 : 1); ++rep_) if (EN(10) && IN(pb + 9)) { PHASE_IDS(); pg8::Gemm g{WSP(bf16, WS_CAT), WSP(bf16, WS_WOUT), M, DM, DM}; pg8::StaticOrder S; S.init(M, DM, G, bid); pg8::EpiBf16P E{WSP(bf16, WS_Y), DM, nullptr, nullptr};
                    pg8::gemm_phase<pg8::EpiBf16P, pg8::StaticOrder, true, true>(lds, g, S, E); }
                SEAM(pb + 9);
                for (int rep_ = 0; rep_ < (DUP(11) ? 2 : 1); ++rep_) if (EN(11) && IN(pb + 10)) { PHASE_IDS(); float* hbuf = HBUF(); const bf16* Y = WSP(bf16, WS_Y); float* RS = WSP(float, WS_RS); const float* gpost = INP(25) + (size_t)L * DM; const float* gpre = INP(26) + (size_t)L * DM;
                    bf16* H16 = WSP(bf16, WS_H16);
                    for (int m = gw; m < M; m += NGW) norm_row<false, false, true>(H16 + (size_t)m * DM, H16 + (size_t)m * DM, Y + (size_t)m * DM, rep_ ? 0.f : 1.0f, gpost, RS + m, lane); }
                SEAM(pb + 10);
            } else {
                for (int rep_ = 0; rep_ < (DUP(12) ? 2 : 1); ++rep_) if (EN(12) && IN(pb + 14)) { PHASE_IDS(); pg8::Gemm g{WSP(bf16, WS_H16), WSP(bf16, WS_WPG), M, DM, DM}; pg8::StaticOrder S; S.init(M, DM, G, bid); pg8::EpiPle E{WSP(bf16, WS_Y), WSP(bf16, WS_PPB), DM, WSP(float, WS_RS)};
                    pg8::gemm_phase<pg8::EpiPle, pg8::StaticOrder, true, true>(lds, g, S, E); }
                SEAM(pb + 14);
                for (int rep_ = 0; rep_ < (DUP(13) ? 2 : 1); ++rep_) if (EN(13) && IN(pb + 15)) { PHASE_IDS(); float* hbuf = HBUF(); const bf16* Y = WSP(bf16, WS_Y); float* RS = WSP(float, WS_RS); bf16* H16 = WSP(bf16, WS_H16); const float* gpost = INP(34) + (size_t)L * DM;
                    if (L + 1 < DEPTH) { const float* gpre = INP(3) + (size_t)(L + 1) * DM;
                        for (int m = gw; m < M; m += NGW) norm_row<false, false, true>(H16 + (size_t)m * DM, H16 + (size_t)m * DM, Y + (size_t)m * DM, rep_ ? 0.f : 1.0f, gpost, RS + m, lane); }
                    else { for (int m = gw; m < M; m += NGW) norm_row<false, true, false>(H16 + (size_t)m * DM, hbuf + (size_t)m * DM, Y + (size_t)m * DM, rep_ ? 0.f : 1.0f, gpost, nullptr, lane); } }
            }
        }
    }
#undef IN
#undef SEAM
}

extern "C" void kernel_launch(void* const* d_in, const int* in_sizes, int n_in, void* d_out, int out_size, void* d_ws, size_t ws_size, hipStream_t stream) {
    static int grid = 0;
    if (grid == 0) {
        if (n_in != 35 || out_size != M * DM || ws_size < WS_END) { fprintf(stderr, "kernel_launch: unexpected shapes (n_in %d, out %d, ws %zu < %zu)\n", n_in, out_size, ws_size, (size_t)WS_END); grid = -1; return; }
        int dev = 0, cus = 0, per_cu = 0;
        if (hipGetDevice(&dev) != hipSuccess || hipDeviceGetAttribute(&cus, hipDeviceAttributeMultiprocessorCount, dev) != hipSuccess) { grid = -1; return; }
        if (hipFuncSetAttribute((const void*)fwd_kernel, hipFuncAttributeMaxDynamicSharedMemorySize, LDS_BYTES) != hipSuccess) { fprintf(stderr, "kernel_launch: hipFuncSetAttribute failed\n"); grid = -1; return; }
        if (hipOccupancyMaxActiveBlocksPerMultiprocessor(&per_cu, (const void*)fwd_kernel, NTHR, LDS_BYTES) != hipSuccess || per_cu < 1) fprintf(stderr, "kernel_launch: occupancy query says %d\n", per_cu);
        (void)hipGetLastError();
        grid = cus;
    }
    if (grid < 0) return;
    (void)hipMemsetAsync((char*)d_ws + WS_CTL, 0, CTL_ZERO_BYTES, stream);
    Args a; memset(&a, 0, sizeof(a));
    for (int i = 0; i < 35; ++i) a.in[i] = d_in[i];
    a.out = (float*)d_out; a.ws = (unsigned char*)d_ws;
#if MK_SPLIT
    for (int ph = 0; ph < NPHASES; ++ph) { a.ph_lo = ph; a.ph_hi = ph + 1; hipLaunchKernelGGL(fwd_kernel, dim3(grid), dim3(NTHR), LDS_BYTES, stream, a); }
#else
    a.ph_lo = 0; a.ph_hi = NPHASES; hipLaunchKernelGGL(fwd_kernel, dim3(grid), dim3(NTHR), LDS_BYTES, stream, a);
#endif
}
```

```cpp
#include <hip/hip_runtime.h>
#include <cstdio>
#include <cstdint>
#include <cstring>
#include <cmath>
namespace pg8 {
#define PG8_LAS __attribute__((address_space(3)))
typedef unsigned short bf16_t;
typedef short bf16x8 __attribute__((ext_vector_type(8)));
typedef float f32x4 __attribute__((ext_vector_type(4)));
typedef unsigned u32x4 __attribute__((ext_vector_type(4)));
constexpr int BM = 256, BK = 64, HALF = 128, HTB = HALF * BK * 2  , STAGE_BYTES = 8 * HTB, NXCD = 8, WGM = 8;

__host__ __device__ __forceinline__ int lds_byte(int r, int c) { const int st = (r >> 4) * 2 + (c >> 5), rr = r & 15, cc = c & 31, ob = rr * 64 + cc * 2; return st * 1024 + (ob ^ (((ob >> 9) & 1) << 5)); }
__host__ __device__ __forceinline__ void stage_rc(int b, int& R, int& C) { const int st = b / 1024, sb = b % 1024, swz = sb ^ (((sb >> 9) & 1) << 5); R = (st >> 1) * 16 + swz / 64; C = (st & 1) * 32 + (swz % 64) / 2; }
__host__ __device__ __forceinline__ int perm32(int rho) { const int n = rho >> 4, i = rho & 15; return 8 * (i >> 2) + 4 * n + (i & 3); }

struct Unit { int pm, pn; };
struct Gemm { const bf16_t* A; const bf16_t* Bt; int M, N, K; };

struct StaticOrder {
    int nM, nN, nwg, G, c, wgm;
    __host__ __device__ void init(int M, int N, int G_, int c_, int wgm_ = 4) { nM = M / BM; nN = N / BM; nwg = nM * nN; G = G_; c = c_; wgm = wgm_; }
    __host__ __device__ bool next(int i, Unit& u) const {
        const long L = (long)i * G + c; if (L >= nwg) return false;
        int wgid = (int)L; { const int q = nwg / NXCD, r = nwg % NXCD, xcd = wgid % NXCD, off = wgid / NXCD; wgid = (xcd < r ? xcd * (q + 1) : r * (q + 1) + (xcd - r) * q) + off; }
        const int nig = wgm * nN, gid = wgid / nig, fm = gid * wgm, gsz = (nM - fm) < wgm ? (nM - fm) : wgm;
        u.pm = fm + ((wgid % nig) % gsz); u.pn = (wgid % nig) / gsz; return true;
    }
    __device__ __forceinline__ void a_ready(const Unit&) const {}
    __device__ __forceinline__ void done(const Unit&) const {}
};

__device__ __forceinline__ unsigned cvt_pk_bf16(float lo, float hi) { unsigned r; asm volatile("v_cvt_pk_bf16_f32 %0, %1, %2" : "=v"(r) : "v"(lo), "v"(hi)); return r; }
__device__ __forceinline__ float sigm(float x) { return __builtin_amdgcn_rcpf(1.0f + __builtin_amdgcn_exp2f(-1.4426950408889634f * x)); }
typedef unsigned u32x2 __attribute__((ext_vector_type(2)));
#define PG8_GAS __attribute__((address_space(1)))

struct EpiF32 {
    static constexpr bool PERM = false, AFTER_DRAIN = false;
    float* C; int ldc;
    __device__ __forceinline__ void pre(const Unit&, int, int, float (&)[8]) const {}
    __device__ __forceinline__ void operator()(const f32x4 (&acc)[2][2][4][2], const Unit& u, int wr, int wc, int fr, int fq, const float (&)[8]) const {
        const int row0 = u.pm * BM + wr * 64 + fr, col0 = u.pn * BM + wc * 32 + 4 * fq;
#pragma unroll
        for (int ai = 0; ai < 2; ++ai)
#pragma unroll
            for (int m = 0; m < 4; ++m) { float* rowp = C + (size_t)(row0 + ai * HALF + m * 16) * ldc + col0;
#pragma unroll
                for (int bj = 0; bj < 2; ++bj)
#pragma unroll
                    for (int n = 0; n < 2; ++n) *(PG8_GAS f32x4*)(rowp + bj * HALF + n * 16) = acc[ai][bj][m][n]; }
    }
};
struct EpiBf16P {
    static constexpr bool PERM = true, AFTER_DRAIN = false;
    bf16_t* O; int ldc; const float* bias; const float* rsc;
    __device__ __forceinline__ void pre(const Unit& u, int wr, int fr, float (&rsp)[8]) const { const int row0 = u.pm * BM + wr * 64 + fr;
#pragma unroll
        for (int i = 0; i < 8; ++i) rsp[i] = rsc ? ((const PG8_GAS float*)rsc)[row0 + (i >> 2) * HALF + (i & 3) * 16] : 1.0f; }
    __device__ __forceinline__ void operator()(const f32x4 (&acc)[2][2][4][2], const Unit& u, int wr, int wc, int fr, int fq, const float (&rsp)[8]) const {
        const int row0 = u.pm * BM + wr * 64 + fr; const int col0 = u.pn * BM + wc * 32 + 8 * fq;
        float rs[2][4];
#pragma unroll
        for (int ai = 0; ai < 2; ++ai)
#pragma unroll
            for (int m = 0; m < 4; ++m) rs[ai][m] = rsp[ai * 4 + m];
        f32x4 bv[2][2];
#pragma unroll
        for (int bj = 0; bj < 2; ++bj)
#pragma unroll
            for (int n = 0; n < 2; ++n) bv[bj][n] = bias ? *(const PG8_GAS f32x4*)(bias + col0 + bj * HALF + 4 * n) : (f32x4){0.f, 0.f, 0.f, 0.f};
#pragma unroll
        for (int ai = 0; ai < 2; ++ai)
#pragma unroll
            for (int m = 0; m < 4; ++m) { bf16_t* rowp = O + (size_t)(row0 + ai * HALF + m * 16) * ldc + col0;
#pragma unroll
                for (int bj = 0; bj < 2; ++bj) { const f32x4 v0 = acc[ai][bj][m][0] * rs[ai][m] + bv[bj][0], v1 = acc[ai][bj][m][1] * rs[ai][m] + bv[bj][1];
                    u32x4 w; w.x = cvt_pk_bf16(v0[0], v0[1]); w.y = cvt_pk_bf16(v0[2], v0[3]); w.z = cvt_pk_bf16(v1[0], v1[1]); w.w = cvt_pk_bf16(v1[2], v1[3]);
                    __builtin_nontemporal_store(w, (PG8_GAS u32x4*)(rowp + bj * HALF)); } }
    }
};
struct EpiSwiglu {
    static constexpr bool PERM = true, AFTER_DRAIN = false;
    bf16_t* O; int ldc; const float* rsc;
    __device__ __forceinline__ void pre(const Unit& u, int wr, int fr, float (&rsp)[8]) const { const int row0 = u.pm * BM + wr * 64 + fr;
#pragma unroll
        for (int i = 0; i < 8; ++i) rsp[i] = rsc ? ((const PG8_GAS float*)rsc)[row0 + (i >> 2) * HALF + (i & 3) * 16] : 1.0f; }
    __device__ __forceinline__ void operator()(const f32x4 (&acc)[2][2][4][2], const Unit& u, int wr, int wc, int fr, int fq, const float (&rsp)[8]) const {
        const int row0 = u.pm * BM + wr * 64 + fr; const int col0 = u.pn * HALF + wc * 32 + 8 * fq;
        float rs[2][4];
#pragma unroll
        for (int ai = 0; ai < 2; ++ai)
#pragma unroll
            for (int m = 0; m < 4; ++m) rs[ai][m] = rsp[ai * 4 + m];
#pragma unroll
        for (int ai = 0; ai < 2; ++ai)
#pragma unroll
            for (int m = 0; m < 4; ++m) { bf16_t* rowp = O + (size_t)(row0 + ai * HALF + m * 16) * ldc + col0;
                float v[8];
#pragma unroll
                for (int n = 0; n < 2; ++n)
#pragma unroll
                    for (int j = 0; j < 4; ++j) { const float g = acc[ai][0][m][n][j] * rs[ai][m], up = acc[ai][1][m][n][j] * rs[ai][m]; v[n * 4 + j] = g * sigm(g) * up; }
                u32x4 w; w.x = cvt_pk_bf16(v[0], v[1]); w.y = cvt_pk_bf16(v[2], v[3]); w.z = cvt_pk_bf16(v[4], v[5]); w.w = cvt_pk_bf16(v[6], v[7]);
                __builtin_nontemporal_store(w, (PG8_GAS u32x4*)rowp); }
    }
};
struct EpiPle {
    static constexpr bool PERM = true, AFTER_DRAIN = false;
    bf16_t* O; const bf16_t* PP; int ldc; const float* rsc;
    __device__ __forceinline__ void pre(const Unit& u, int wr, int fr, float (&rsp)[8]) const { const int row0 = u.pm * BM + wr * 64 + fr;
#pragma unroll
        for (int i = 0; i < 8; ++i) rsp[i] = rsc ? ((const PG8_GAS float*)rsc)[row0 + (i >> 2) * HALF + (i & 3) * 16] : 1.0f; }
    __device__ __forceinline__ void operator()(const f32x4 (&acc)[2][2][4][2], const Unit& u, int wr, int wc, int fr, int fq, const float (&rsp)[8]) const {
        const int row0 = u.pm * BM + wr * 64 + fr, col0 = u.pn * BM + wc * 32 + 8 * fq;
#pragma unroll
        for (int ai = 0; ai < 2; ++ai)
#pragma unroll
            for (int m = 0; m < 4; ++m) { const size_t off = (size_t)(row0 + ai * HALF + m * 16) * ldc + col0; const float rsv = rsp[ai * 4 + m];
#pragma unroll
                for (int bj = 0; bj < 2; ++bj) { const u32x4 pw = *(const PG8_GAS u32x4*)(PP + off + bj * HALF); const f32x4 a0 = acc[ai][bj][m][0] * rsv, a1 = acc[ai][bj][m][1] * rsv;
                    u32x4 w;
                    w.x = cvt_pk_bf16(sigm(a0[0]) * __uint_as_float(pw.x << 16), sigm(a0[1]) * __uint_as_float(pw.x & 0xffff0000u));
                    w.y = cvt_pk_bf16(sigm(a0[2]) * __uint_as_float(pw.y << 16), sigm(a0[3]) * __uint_as_float(pw.y & 0xffff0000u));
                    w.z = cvt_pk_bf16(sigm(a1[0]) * __uint_as_float(pw.z << 16), sigm(a1[1]) * __uint_as_float(pw.z & 0xffff0000u));
                    w.w = cvt_pk_bf16(sigm(a1[2]) * __uint_as_float(pw.w << 16), sigm(a1[3]) * __uint_as_float(pw.w & 0xffff0000u));
                    __builtin_nontemporal_store(w, (PG8_GAS u32x4*)(O + off + bj * HALF)); } }
    }
};
template <class Epi, class Sched, bool ALIGN_EPI = false, bool SP2 = false>
__device__ __forceinline__ void gemm_phase(PG8_LAS unsigned char* lds, const Gemm g, const Sched& S, const Epi& E) {
    int tid_o = threadIdx.x; asm volatile("" : "+v"(tid_o));
    const int tid = tid_o, wid = __builtin_amdgcn_readfirstlane(tid >> 6), lane = tid & 63, wr = wid >> 2, wc = wid & 3, fr = lane & 15, fq = lane >> 4;
    const int K = g.K, nt = K / BK;
    unsigned voffA[2], voffB[2];
#pragma unroll
    for (int i = 0; i < 2; ++i) { int R, C; stage_rc(tid * 16 + i * 8192, R, C); const int Rb = Epi::PERM ? ((R & ~31) + perm32(R & 31)) : R;
        voffA[i] = (unsigned)(R * K + C) * 2u; voffB[i] = (unsigned)(Rb * K + C) * 2u; }
    const size_t kstep = (size_t)(BK * 2);
    const size_t hstep = (size_t)HALF * K * 2;
    const size_t tstep = 2 * hstep;
    const unsigned ldsw = (unsigned)wid * 1024u;
    const int aoff = lds_byte(wr * 64 + fr, fq * 8), boff = lds_byte(wc * 32 + fr, fq * 8);
#define PG8_SA(b, h) (((b) * 2 + (h)) * HTB)
#define PG8_SB(b, h) ((4 + (b) * 2 + (h)) * HTB)
#define PG8_STAGE(bufoff, gbase, voff) do { _Pragma("unroll") for (int _i = 0; _i < 2; ++_i) \
        __builtin_amdgcn_global_load_lds((const unsigned*)((const char*)(gbase) + (voff)[_i]), (PG8_LAS unsigned*)(lds + (bufoff) + ldsw + _i * 8192), 16, 0, 0); } while (0)
#define PG8_LDA(dst, b, h) do { _Pragma("unroll") for (int m = 0; m < 4; ++m) _Pragma("unroll") for (int k = 0; k < 2; ++k) dst[m][k] = *(const PG8_LAS bf16x8*)(lds + PG8_SA(b, h) + aoff + m * 2048 + k * 1024); } while (0)
#define PG8_LDB(dst, b, h) do { _Pragma("unroll") for (int n = 0; n < 2; ++n) _Pragma("unroll") for (int k = 0; k < 2; ++k) dst[n][k] = *(const PG8_LAS bf16x8*)(lds + PG8_SB(b, h) + boff + n * 2048 + k * 1024); } while (0)
#define PG8_MMA(ai, bj, At, Bt) do { __builtin_amdgcn_s_setprio(1); _Pragma("unroll") for (int m = 0; m < 4; ++m) _Pragma("unroll") for (int n = 0; n < 2; ++n) _Pragma("unroll") for (int k = 0; k < 2; ++k) \
        acc[ai][bj][m][n] = __builtin_amdgcn_mfma_f32_16x16x32_bf16(Bt[n][k], At[m][k], acc[ai][bj][m][n], 0, 0, 0); __builtin_amdgcn_s_setprio(0); } while (0)
#define PG8_WAIT_V(n) asm volatile("s_waitcnt vmcnt(" #n ")" ::: "memory")
#define PG8_WAIT_L(n) asm volatile("s_waitcnt lgkmcnt(" #n ")" ::: "memory")
#define PG8_BAR __builtin_amdgcn_s_barrier()
#define PG8_SCHED __builtin_amdgcn_sched_barrier(0)
    Unit cur, nxt; int ui = 0;
    if (!S.next(0, cur)) return;
    f32x4 acc[2][2][4][2];
#pragma unroll
    for (int a = 0; a < 2; ++a)
#pragma unroll
        for (int b = 0; b < 2; ++b)
#pragma unroll
            for (int m = 0; m < 4; ++m)
#pragma unroll
                for (int n = 0; n < 2; ++n) acc[a][b][m][n] = (f32x4){0.f, 0.f, 0.f, 0.f};
    bf16x8 At[4][2], B0[2][2], B1[2][2];
    const char* cA = (const char*)g.A + (size_t)cur.pm * tstep; const char* cB = (const char*)g.Bt + (size_t)cur.pn * tstep;
    S.a_ready(cur);
    if constexpr (SP2) {
        PG8_STAGE(PG8_SB(0, 0), cB, voffB); PG8_STAGE(PG8_SB(0, 1), cB + hstep, voffB); PG8_STAGE(PG8_SA(0, 0), cA, voffA); PG8_STAGE(PG8_SA(0, 1), cA + hstep, voffA);
        if (wr == 1) PG8_BAR;
        PG8_WAIT_V(2); PG8_BAR;
        PG8_STAGE(PG8_SB(1, 0), cB + kstep, voffB); PG8_STAGE(PG8_SA(1, 0), cA + kstep, voffA); PG8_STAGE(PG8_SB(1, 1), cB + hstep + kstep, voffB);
        PG8_WAIT_V(6); PG8_BAR;
    } else {
        PG8_STAGE(PG8_SB(0, 0), cB, voffB); PG8_STAGE(PG8_SA(0, 0), cA, voffA); PG8_STAGE(PG8_SB(0, 1), cB + hstep, voffB); PG8_STAGE(PG8_SA(0, 1), cA + hstep, voffA);
        if (wr == 1) PG8_BAR;
        PG8_WAIT_V(4); PG8_BAR;
        PG8_STAGE(PG8_SB(1, 0), cB + kstep, voffB); PG8_STAGE(PG8_SA(1, 0), cA + kstep, voffA); PG8_STAGE(PG8_SB(1, 1), cB + hstep + kstep, voffB);
        PG8_WAIT_V(6); PG8_BAR;
    }
    for (;;) {
        const bool has_next = S.next(ui + 1, nxt);
        float rsp[8]; E.pre(cur, wr, fr, rsp);
        const char* nA = has_next ? (const char*)g.A + (size_t)nxt.pm * tstep : cA; const char* nB = has_next ? (const char*)g.Bt + (size_t)nxt.pn * tstep : cB;
        for (int t = 0; t < nt; t += 2) {
            const bool last = (t == nt - 2);
            const char* a1 = cA + (size_t)(t + 1) * kstep;
            const char* a2 = last ? nA : cA + (size_t)(t + 2) * kstep; const char* b2 = last ? nB : cB + (size_t)(t + 2) * kstep;
            const char* a3 = a2 + kstep; const char* b3 = b2 + kstep;
            if (last && has_next) S.a_ready(nxt);
            if constexpr (SP2) {
            PG8_LDB(B0, 0, 0); PG8_LDB(B1, 0, 1); PG8_SCHED; PG8_LDA(At, 0, 0); PG8_STAGE(PG8_SA(1, 1), a1 + hstep, voffA);
            PG8_WAIT_V(8); PG8_WAIT_L(0); PG8_BAR; PG8_MMA(0, 0, At, B0); PG8_MMA(0, 1, At, B1); PG8_BAR; PG8_SCHED;
            PG8_LDA(At, 0, 1); PG8_STAGE(PG8_SB(0, 0), b2, voffB); PG8_STAGE(PG8_SB(0, 1), b2 + hstep, voffB); PG8_STAGE(PG8_SA(0, 0), a2, voffA);
            PG8_WAIT_V(8); PG8_WAIT_L(0); PG8_BAR; PG8_MMA(1, 0, At, B0); PG8_MMA(1, 1, At, B1); PG8_BAR; PG8_SCHED;
            PG8_LDB(B0, 1, 0); PG8_LDB(B1, 1, 1); PG8_SCHED; PG8_LDA(At, 1, 0); PG8_STAGE(PG8_SA(0, 1), a2 + hstep, voffA);
            PG8_WAIT_V(8); PG8_WAIT_L(0); PG8_BAR; PG8_MMA(0, 0, At, B0); PG8_MMA(0, 1, At, B1); PG8_BAR; PG8_SCHED;
            PG8_LDA(At, 1, 1); PG8_STAGE(PG8_SB(1, 0), b3, voffB); PG8_STAGE(PG8_SB(1, 1), b3 + hstep, voffB); PG8_STAGE(PG8_SA(1, 0), a3, voffA);
            PG8_WAIT_V(8); PG8_WAIT_L(0); PG8_BAR; PG8_MMA(1, 0, At, B0); PG8_MMA(1, 1, At, B1); PG8_BAR; PG8_SCHED;
            } else {
            PG8_LDB(B0, 0, 0); PG8_SCHED; PG8_LDA(At, 0, 0); PG8_STAGE(PG8_SA(1, 1), a1 + hstep, voffA);
            PG8_WAIT_L(8); PG8_BAR; PG8_WAIT_L(0); PG8_MMA(0, 0, At, B0); PG8_BAR; PG8_SCHED;
            PG8_LDB(B1, 0, 1); PG8_STAGE(PG8_SB(0, 0), b2, voffB);
            PG8_BAR; PG8_WAIT_L(0); PG8_MMA(0, 1, At, B1); PG8_BAR;
            PG8_LDA(At, 0, 1); PG8_STAGE(PG8_SA(0, 0), a2, voffA);
            PG8_BAR; PG8_WAIT_L(0); PG8_MMA(1, 0, At, B0); PG8_BAR; PG8_SCHED;
            PG8_STAGE(PG8_SB(0, 1), b2 + hstep, voffB);
            PG8_WAIT_V(6); PG8_BAR; PG8_MMA(1, 1, At, B1); PG8_BAR;
            PG8_LDB(B0, 1, 0); PG8_SCHED; PG8_LDA(At, 1, 0); PG8_STAGE(PG8_SA(0, 1), a2 + hstep, voffA);
            PG8_WAIT_L(8); PG8_BAR; PG8_WAIT_L(0); PG8_MMA(0, 0, At, B0); PG8_BAR; PG8_SCHED;
            PG8_LDB(B1, 1, 1); PG8_STAGE(PG8_SB(1, 0), b3, voffB);
            PG8_BAR; PG8_WAIT_L(0); PG8_MMA(0, 1, At, B1); PG8_BAR;
            PG8_LDA(At, 1, 1); PG8_STAGE(PG8_SA(1, 0), a3, voffA);
            PG8_BAR; PG8_WAIT_L(0); PG8_MMA(1, 0, At, B0); PG8_BAR; PG8_SCHED;
            PG8_STAGE(PG8_SB(1, 1), b3 + hstep, voffB);
            PG8_WAIT_V(6); PG8_BAR; PG8_MMA(1, 1, At, B1); PG8_BAR;
            }
        }
        if constexpr (ALIGN_EPI) { if (wr == 0) PG8_BAR; }
        if constexpr (!Epi::AFTER_DRAIN) { E(acc, cur, wr, wc, fr, fq, rsp); S.done(cur); }
        if (!has_next) break;
#pragma unroll
        for (int a = 0; a < 2; ++a)
#pragma unroll
            for (int b = 0; b < 2; ++b)
#pragma unroll
                for (int m = 0; m < 4; ++m)
#pragma unroll
                    for (int n = 0; n < 2; ++n) acc[a][b][m][n] = (f32x4){0.f, 0.f, 0.f, 0.f};
        cur = nxt; cA = nA; cB = nB; ++ui;
        if constexpr (ALIGN_EPI) { if (wr == 1) PG8_BAR; }
    }
    PG8_WAIT_V(0);
    if constexpr (!ALIGN_EPI) { if (wr == 0) PG8_BAR; }
    PG8_BAR;
    if constexpr (Epi::AFTER_DRAIN) { E.fused(acc, cur, wr, wc, fr, fq, lds, wid, lane); S.done(cur); }
#undef PG8_SA
#undef PG8_SB
#undef PG8_STAGE
#undef PG8_LDA
#undef PG8_LDB
#undef PG8_MMA
#undef PG8_WAIT_V
#undef PG8_WAIT_L
#undef PG8_BAR
#undef PG8_SCHED
}
}

#ifndef MK_SPLIT
#define MK_SPLIT 0
#endif
#define DEVI __device__ __forceinline__
#define LAS __attribute__((address_space(3)))
#define GAS __attribute__((address_space(1)))
typedef unsigned short bf16;
typedef float f32x4 __attribute__((ext_vector_type(4)));
typedef float f32x16 __attribute__((ext_vector_type(16)));
typedef short bf16x8 __attribute__((ext_vector_type(8)));
typedef short s16x4 __attribute__((ext_vector_type(4)));
typedef short v4i16_t __attribute__((ext_vector_type(4)));
typedef unsigned u32x4 __attribute__((ext_vector_type(4)));
typedef unsigned u32x2 __attribute__((ext_vector_type(2)));
typedef GAS unsigned gu32;

constexpr int NWAVES = 8, NTHR = 512;
constexpr int BATCH = 2, SEQ = 8192, M = BATCH * SEQ, DM = 4096, DFF = 11008, DEPTH = 2;
constexpr int NIN = 10824, NINP = 11008;
constexpr int C_RQ = 0, C_RK = 1024, C_RV = 2048, C_RG = 3072, C_CQ = 4096, C_CKV = 5120, C_KR = 5632, C_FQ = 5696, C_FK = 6720, C_FV = 7744, C_FF = 8768, C_CIN = 8776;
constexpr float NORM_EPS = 1e-6f, LN_EPS = 1e-5f;
constexpr float LOG2E = 1.4426950408889634f;

constexpr size_t MiB = 1u << 20;
constexpr size_t WS_CTL = 0, CTL_ZERO_BYTES = 1 * MiB;
constexpr size_t WS_WGU1 = 1 * MiB, WS_WD1 = 173 * MiB, WS_WGU2 = 259 * MiB, WS_WD2 = 431 * MiB, WS_WIN = 517 * MiB, WS_WOUT = 603 * MiB, WS_WPG = 635 * MiB,
                 WS_WPP = 667 * MiB, WS_WUQ = 669 * MiB, WS_WUKV = 672 * MiB, WS_WPW = 674 * MiB;
constexpr size_t WS_HN = 676 * MiB, WS_ACT = 804 * MiB, WS_Y = 1148 * MiB, WS_CAT = 1404 * MiB, WS_PPB = 1532 * MiB, WS_P16 = 1660 * MiB;
constexpr size_t WS_COS128 = 1676 * MiB, WS_SIN128 = 1680 * MiB, WS_COS64 = 1684 * MiB, WS_SIN64 = 1686 * MiB;
constexpr size_t WS_RQ = 1688 * MiB, WS_RK = 1720 * MiB, WS_CQN = 1752 * MiB, WS_CKVN = 1784 * MiB, WS_KR = 1800 * MiB, WS_LOGF = 1802 * MiB, WS_CUM2 = 1803 * MiB,
                 WS_U = 1804 * MiB, WS_YC = 1836 * MiB, WS_MQ = 1868 * MiB, WS_KVR = 1916 * MiB, WS_KVC = 1980 * MiB, WS_ST = 2044 * MiB, WS_H16 = 2076 * MiB, WS_RS = 2204 * MiB, WS_END = 2205 * MiB;
constexpr int CW_BAR = 4096;
constexpr int CW_QK = 16384;

constexpr int RING_BYTES = 131072, LDSCTL_OFF = RING_BYTES, LDS_BYTES = 147456;

#define LDS_WAIT() asm volatile("s_waitcnt lgkmcnt(0)" ::: "memory")
DEVI float bf2f(unsigned b) { return __uint_as_float(b << 16); }
DEVI unsigned f2bf(float f) { unsigned u = __float_as_uint(f); return (u + 0x7fffu + ((u >> 16) & 1u)) >> 16; }
DEVI unsigned pk2(float lo, float hi) { return pg8::cvt_pk_bf16(lo, hi); }
DEVI void unpack8(const u32x4 w, float (&f)[8]) {
    f[0] = __uint_as_float(w.x << 16); f[1] = __uint_as_float(w.x & 0xffff0000u); f[2] = __uint_as_float(w.y << 16); f[3] = __uint_as_float(w.y & 0xffff0000u);
    f[4] = __uint_as_float(w.z << 16); f[5] = __uint_as_float(w.z & 0xffff0000u); f[6] = __uint_as_float(w.w << 16); f[7] = __uint_as_float(w.w & 0xffff0000u); }
DEVI u32x4 pack8(const float (&f)[8]) { u32x4 w; w.x = pk2(f[0], f[1]); w.y = pk2(f[2], f[3]); w.z = pk2(f[4], f[5]); w.w = pk2(f[6], f[7]); return w; }
DEVI float wave_sum(float v) {
#pragma unroll
    for (int o = 1; o < 64; o <<= 1) v += __shfl_xor(v, o);
    return v; }
DEVI float sigm(float x) { return __builtin_amdgcn_rcpf(1.0f + __builtin_amdgcn_exp2f(-LOG2E * x)); }
template <int MASK> DEVI float shxor(float v) { static_assert(MASK > 0 && MASK < 32, "ds_swizzle bit mode"); return __builtin_bit_cast(float, __builtin_amdgcn_ds_swizzle(__builtin_bit_cast(int, v), (MASK << 10) | 0x1f)); }
DEVI float max32(float v) { unsigned a = __builtin_bit_cast(unsigned, v), b = a; asm volatile("s_nop 1\n\tv_permlane32_swap_b32 %0, %1" : "+v"(a), "+v"(b)); return fmaxf(__builtin_bit_cast(float, a), __builtin_bit_cast(float, b)); }
DEVI float wave_max(float v) { v = fmaxf(v, shxor<1>(v)); v = fmaxf(v, shxor<2>(v)); v = fmaxf(v, shxor<4>(v)); v = fmaxf(v, shxor<8>(v)); v = fmaxf(v, shxor<16>(v)); return max32(v); }
DEVI int crow(int r, int hi) { return (r & 3) + 8 * (r >> 2) + 4 * hi; }
DEVI s16x4 vtr(const LAS unsigned char* p) { return __builtin_bit_cast(s16x4, __builtin_amdgcn_ds_read_tr16_b64_v4i16((LAS v4i16_t*)p)); }
DEVI bf16x8 cat44(s16x4 a, s16x4 b) { return (bf16x8){a[0], a[1], a[2], a[3], b[0], b[1], b[2], b[3]}; }
DEVI bf16x8 packp8(const f32x16& p, int s) { u32x4 w; w.x = pg8::cvt_pk_bf16(p[8 * s + 0], p[8 * s + 1]); w.y = pg8::cvt_pk_bf16(p[8 * s + 2], p[8 * s + 3]);
    w.z = pg8::cvt_pk_bf16(p[8 * s + 4], p[8 * s + 5]); w.w = pg8::cvt_pk_bf16(p[8 * s + 6], p[8 * s + 7]); return __builtin_bit_cast(bf16x8, w); }
#define MFMA32(a, b, c) __builtin_amdgcn_mfma_f32_32x32x16_bf16((a), (b), (c), 0, 0, 0)

DEVI unsigned long long rfl64(unsigned long long v) { const unsigned lo = __builtin_amdgcn_readfirstlane((unsigned)v), hi = __builtin_amdgcn_readfirstlane((unsigned)(v >> 32)); return ((unsigned long long)hi << 32) | lo; }
#define XB_TMO      128
#define XB_XCNT(j)  (256  + 64 * (j))
#define XB_XSUB(j)  (1280 + 64 * (j))
#define XB_XGEN(j)  (2304 + 64 * (j))
#define XB_TOP      3328
#define XB_TOPGEN   3392
#define XCD_BAR_WORDS 3456
#define XB_SPIN_CAP (1u << 18)

__device__ __forceinline__ unsigned xb_ld(unsigned* p)              { return __hip_atomic_load(p, __ATOMIC_RELAXED, __HIP_MEMORY_SCOPE_AGENT); }
__device__ __forceinline__ unsigned xb_add(unsigned* p, unsigned v) { return __hip_atomic_fetch_add(p, v, __ATOMIC_RELAXED, __HIP_MEMORY_SCOPE_AGENT); }
__device__ __forceinline__ unsigned xb_xcc_id() { return (unsigned)__builtin_amdgcn_s_getreg((3 << 11) | 20) & 0xFu; }
#define XB_SPIN(cond, bar) do { unsigned _sp = 0; while (cond) { __builtin_amdgcn_s_sleep(1); \
    if ((++_sp & 255u) == 0u) { if (xb_ld(&(bar)[XB_TMO])) break; if (_sp > XB_SPIN_CAP) { atomicAdd(&(bar)[XB_TMO], 1u); break; } } } } while (0)

struct XcdBarrier {
    unsigned* bar; unsigned x;
    volatile LAS unsigned* st;
};

__device__ __forceinline__ XcdBarrier xcd_barrier_post(unsigned* bar, volatile LAS unsigned* st) {
    XcdBarrier b; b.bar = bar; b.x = xb_xcc_id(); b.st = st;
    if (threadIdx.x == 0) (void)xb_add(&bar[XB_XCNT(b.x)], 1u);
    return b;
}
__device__ __forceinline__ void xcd_barrier_complete(unsigned* bar, unsigned x, unsigned& nloc, unsigned& nx) {
    const unsigned G = gridDim.x * gridDim.y * gridDim.z;
    unsigned sum, cnt, mine, sp = 0u;
    for (;;) {
        sum = 0u; cnt = 0u; mine = 0u;
#pragma unroll
        for (unsigned j = 0; j < 16; ++j) { const unsigned c = xb_ld(&bar[XB_XCNT(j)]); sum += c; cnt += (c > 0u) ? 1u : 0u; mine = (j == x) ? c : mine; }
        if (sum == G) break;
        __builtin_amdgcn_s_sleep(1);
        if ((++sp & 255u) == 0u) { if (xb_ld(&bar[XB_TMO])) break; if (sp > XB_SPIN_CAP) { atomicAdd(&bar[XB_TMO], 1u); break; } }
    }
    nloc = mine > 0u ? mine : 1u; nx = cnt > 0u ? cnt : 1u;
}

__device__ __forceinline__ void xcd_barrier(const XcdBarrier& b) {
    asm volatile("s_waitcnt vmcnt(0)" ::: "memory");
    __syncthreads();
    if (threadIdx.x == 0) {
        unsigned* bar = b.bar;
        __builtin_amdgcn_s_waitcnt(0);
        unsigned nloc = b.st[0], nx = b.st[1];
        if (nloc == 0u) { xcd_barrier_complete(bar, b.x, nloc, nx); b.st[0] = nloc; b.st[1] = nx; }
        const unsigned old = xb_add(&bar[XB_XSUB(b.x)], 1u);
        const unsigned gen = old / nloc;
        if (old + 1u == (gen + 1u) * nloc) {
            __builtin_amdgcn_fence(__ATOMIC_RELEASE, "agent");
            asm volatile("s_waitcnt vmcnt(0)" ::: "memory");
            const unsigned og = xb_add(&bar[XB_TOP], 1u);
            const unsigned tg = og / nx;
            if (og + 1u == (tg + 1u) * nx) xb_add(&bar[XB_TOPGEN], 1u);
            else XB_SPIN(xb_ld(&bar[XB_TOPGEN]) == tg, bar);
            __builtin_amdgcn_fence(__ATOMIC_ACQUIRE, "agent");
            xb_add(&bar[XB_XGEN(b.x)], 1u);
            asm volatile("s_waitcnt vmcnt(0)" ::: "memory");
        } else {
            XB_SPIN(xb_ld(&bar[XB_XGEN(b.x)]) == gen, bar);
            __builtin_amdgcn_fence(__ATOMIC_ACQUIRE, "agent");
            asm volatile("s_waitcnt vmcnt(0)" ::: "memory");
        }
    }
    __syncthreads();
}

DEVI void tr_item(const float* __restrict__ W, int K, int N, bf16* __restrict__ WT, int dst_row0, LAS float* scr, int k0, int n0, int lane, const float* __restrict__ gk = nullptr) {
    const int c = lane & 31; const bool ok = (n0 + c) < N;
#pragma unroll
    for (int i = 0; i < 32; ++i) { const int kk = 2 * i + (lane >> 5); scr[kk * 33 + c] = ok ? W[(size_t)(k0 + kk) * N + n0 + c] : 0.f; }
    LDS_WAIT(); asm volatile("" ::: "memory");
    const int ch = lane & 7;
    f32x4 g0 = {1.f, 1.f, 1.f, 1.f}, g1 = g0; if (gk) { g0 = *(const f32x4*)(gk + k0 + 8 * ch); g1 = *(const f32x4*)(gk + k0 + 8 * ch + 4); }
#pragma unroll
    for (int j = 0; j < 4; ++j) { const int n = (lane >> 3) + 8 * j; const LAS float* s = scr + (8 * ch) * 33 + n;
        u32x4 o; o.x = pk2(s[0 * 33] * g0[0], s[1 * 33] * g0[1]); o.y = pk2(s[2 * 33] * g0[2], s[3 * 33] * g0[3]); o.z = pk2(s[4 * 33] * g1[0], s[5 * 33] * g1[1]); o.w = pk2(s[6 * 33] * g1[2], s[7 * 33] * g1[3]);
        *(u32x4*)(WT + (size_t)(dst_row0 + n) * K + k0 + 8 * ch) = o; }
    LDS_WAIT(); asm volatile("" ::: "memory");
}

template <bool FIRST, bool LAST, bool HAS_HN, bool GREG = false>
DEVI void norm_row(const void* __restrict__ hin, void* __restrict__ hout, const bf16* __restrict__ y, float coef, const float* __restrict__ gpost, float* __restrict__ hn  , int lane, const f32x4* greg = nullptr) {
    f32x4 v[16];
    if (!GREG) asm volatile("" : "+s"(gpost));
    if (FIRST) {
#pragma unroll
        for (int j = 0; j < 16; ++j) v[j] = ((const f32x4*)hin)[lane + 64 * j];
    } else {
        u32x2 yw[16], hw[16]; float ss = 0.f;
#pragma unroll
        for (int j = 0; j < 16; ++j) yw[j] = ((const u32x2*)y)[lane + 64 * j];
#pragma unroll
        for (int j = 0; j < 16; ++j) hw[j] = ((const u32x2*)hin)[lane + 64 * j];
#pragma unroll
        for (int j = 0; j < 16; ++j) { const float a = __uint_as_float(yw[j].x << 16), b = __uint_as_float(yw[j].x & 0xffff0000u), c = __uint_as_float(yw[j].y << 16), d = __uint_as_float(yw[j].y & 0xffff0000u); ss += (a * a + b * b) + (c * c + d * d); }
        const float rs = coef / sqrtf(wave_sum(ss) * (1.0f / DM) + NORM_EPS);
#pragma unroll
        for (int j = 0; j < 16; ++j) { const f32x4 g = GREG ? greg[j] : ((const f32x4*)gpost)[lane + 64 * j];
            const f32x4 yv = (f32x4){__uint_as_float(yw[j].x << 16), __uint_as_float(yw[j].x & 0xffff0000u), __uint_as_float(yw[j].y << 16), __uint_as_float(yw[j].y & 0xffff0000u)};
            const f32x4 hv = (f32x4){__uint_as_float(hw[j].x << 16), __uint_as_float(hw[j].x & 0xffff0000u), __uint_as_float(hw[j].y << 16), __uint_as_float(hw[j].y & 0xffff0000u)};
            v[j] = hv + yv * rs * g;
            if ((j & 3) == 3) { asm volatile("" : "+v"(v[j - 3]), "+v"(v[j - 2]), "+v"(v[j - 1]), "+v"(v[j]) :: "memory"); } }
    }
    if (LAST) {
#pragma unroll
        for (int j = 0; j < 16; ++j) ((f32x4*)hout)[lane + 64 * j] = v[j];
    } else {
#pragma unroll
        for (int j = 0; j < 16; ++j) { u32x2 o; o.x = pk2(v[j].x, v[j].y); o.y = pk2(v[j].z, v[j].w); ((u32x2*)hout)[lane + 64 * j] = o; }
    }
    if (HAS_HN) {
        float ss = 0.f;
#pragma unroll
        for (int j = 0; j < 16; ++j) ss += (v[j].x * v[j].x + v[j].y * v[j].y) + (v[j].z * v[j].z + v[j].w * v[j].w);
        const float rs = 1.0f / sqrtf(wave_sum(ss) * (1.0f / DM) + NORM_EPS);
        if (lane == 0) *(float*)hn = rs;
    }
    asm volatile("" ::: "memory");
}

DEVI void sincos_d(float ang, float& s_out, float& c_out) {
    const double a = (double)ang; const double q = __builtin_rint(a * 0.63661977236758134308);
    double y = __builtin_fma(-q, 1.57079632679489655800, a); y = __builtin_fma(-q, 6.123233995736766036e-17, y);
    const double y2 = y * y;
    double sp = 1.0 / 6227020800.0; sp = sp * y2 - 1.0 / 39916800.0; sp = sp * y2 + 1.0 / 362880.0; sp = sp * y2 - 1.0 / 5040.0; sp = sp * y2 + 1.0 / 120.0; sp = sp * y2 - 1.0 / 6.0; sp = sp * y2 + 1.0; sp = sp * y;
    double cp = -1.0 / 87178291200.0; cp = cp * y2 + 1.0 / 479001600.0; cp = cp * y2 - 1.0 / 3628800.0; cp = cp * y2 + 1.0 / 40320.0; cp = cp * y2 - 1.0 / 720.0; cp = cp * y2 + 1.0 / 24.0; cp = cp * y2 - 0.5; cp = cp * y2 + 1.0;
    const int qi = ((int)q) & 3;
    const double s = (qi == 0) ? sp : (qi == 1) ? cp : (qi == 2) ? -sp : -cp;
    const double c = (qi == 0) ? cp : (qi == 1) ? -sp : (qi == 2) ? -cp : sp;
    s_out = (float)s; c_out = (float)c;
}
DEVI float inv_freq(int i, double base) { double r = 1.0, b = base;
#pragma unroll
    for (int bit = 0; bit < 6; ++bit) { if ((i >> bit) & 1) r *= b; b *= b; }
    return (float)r; }
DEVI float ret_lg2(int h) {
    const double x = 1.0 / (double)(1 << (5 + h)); double t = x, s = 0.0;
#pragma unroll
    for (int k = 1; k <= 12; ++k) { s += t / (double)k; t *= x; }
    return (float)(-s * 1.4426950408889634074);
}

template <int DK, bool FOX>
DEVI void attn_unit(LAS unsigned char* lds, int b, int qb, const bf16* __restrict__ Qp, int qpitch, const bf16* __restrict__ K1p, int k1pitch, const bf16* __restrict__ K2p, int k2pitch,
                    const bf16* __restrict__ Vp, int vpitch, const float* __restrict__ cum2, bf16* __restrict__ Op, int opitch, float c2, float qkmax2) {
    constexpr int KSTR = (DK == 128) ? 272 : 400, VSTR = 320, NCH = DK / 8, NDS = DK / 16, NPARK = 0, NPRING = 0;
    int tid_o = threadIdx.x; asm volatile("" : "+v"(tid_o));
    const int tid = tid_o, w = __builtin_amdgcn_readfirstlane(tid >> 6), lane = tid & 63, r32 = lane & 31, hi = lane >> 5;
    const int t = qb * 256 + w * 32 + r32;
    const size_t mq = (size_t)b * SEQ + t;
    constexpr int NQR = NDS - NPARK;
    bf16x8 qf[NQR];
#pragma unroll
    for (int ds = 0; ds < NQR; ++ds) qf[ds] = *(const bf16x8*)(Qp + mq * qpitch + 16 * ds + 8 * hi);
    static_assert(3 * (64 * KSTR + 256) + 2 * (64 * VSTR) + 8 * NPRING * 1024 <= RING_BYTES && 2048 + 8 * (NPARK - NPRING) * 1024 <= LDS_BYTES - LDSCTL_OFF, "attention LDS budget");
    LAS unsigned char* qpark = lds + 3 * (64 * KSTR + 256) + 2 * (64 * VSTR) + w * (NPRING * 1024) + lane * 16;
    LAS unsigned char* qpark2 = lds + LDSCTL_OFF + 2048 + w * ((NPARK - NPRING) * 1024) + lane * 16;
    {
#pragma unroll
        for (int ds = NQR; ds < NDS; ++ds) *(LAS bf16x8*)((ds - NQR < NPRING) ? qpark + (ds - NQR) * 1024 : qpark2 + (ds - NQR - NPRING) * 1024) = *(const bf16x8*)(Qp + mq * qpitch + 16 * ds + 8 * hi); }
    float ct2 = 0.f; if (FOX) ct2 = cum2[t];
    f32x16 o[4];
#pragma unroll
    for (int d0 = 0; d0 < 4; ++d0)
#pragma unroll
        for (int r = 0; r < 16; ++r) o[d0][r] = 0.f;
    float m_run = -1e30f, l_run = 0.f;
    const int NT = 4 * (qb + 1), jlast = 4 * qb + (w >> 1);
    const int qfirst = qb * 256 + w * 32;
    int j0 = 0;
    if (FOX) { const float thr = -(2.0f * qkmax2 + 64.0f), cT0 = cum2[qb * 256];
        const int ja = lane, jb = lane + 64;
        const bool da = (ja < NT) && (cT0 - cum2[64 * ja + 63] < thr), db = (jb < NT) && (cT0 - cum2[64 * jb + 63] < thr);
        j0 = __builtin_popcountll(__ballot(da)) + __builtin_popcountll(__ballot(db)); j0 = __builtin_amdgcn_readfirstlane(j0); if (j0 > 4 * qb) j0 = 4 * qb; }
    const size_t mk0 = (size_t)b * SEQ;
    constexpr int KB = 64 * KSTR + 256, VB = 64 * VSTR;
    constexpr int KSPR = KSTR / 16, VSPR = VSTR / 16, NIK = 64 * KSPR / 64, NIV = 64 * VSPR / 64, NKD = (NIK + 7) / 8, NVD = (NIV + 7) / 8;
    constexpr int NKOPS = NKD + (FOX ? 1 : 0), NVOPS = NVD;
    unsigned koff[NKD], voff[NVD]; unsigned k2mask = 0u;
#pragma unroll
    for (int i = 0; i < NKD; ++i) { int n = w + 8 * i; if (n >= NIK) n -= 8; const int s_ = 64 * n + lane, row = s_ / KSPR; int ch = s_ % KSPR; if (ch >= NCH) ch = 0;
        if (ch < 16) koff[i] = (unsigned)(row * k1pitch + ch * 8) * 2u; else { koff[i] = (unsigned)(row * k2pitch + (ch - 16) * 8) * 2u; k2mask |= 1u << i; } }
#pragma unroll
    for (int i = 0; i < NVD; ++i) { int n = w + 8 * i; if (n >= NIV) n -= 8; const int s_ = 64 * n + lane, row = s_ / VSPR; int ch = s_ % VSPR; if (ch >= 16) ch = 0; voff[i] = (unsigned)(row * vpitch + ch * 8) * 2u; }
#define ATT_DMAK(tt) do { const int t_ = (tt) < NTt ? (tt) : NTt - 1; const int j_ = j0 + t_; LAS unsigned char* Kw = lds + ((tt) % 3) * KB; \
        const GAS char* kb1 = (const GAS char*)(K1p + (mk0 + 64 * j_) * k1pitch); const GAS char* kb2 = (const GAS char*)(K2p + (mk0 + 64 * j_) * k2pitch); \
        _Pragma("unroll") for (int i = 0; i < NKD; ++i) { int n = w + 8 * i; if (n >= NIK) n -= 8; const GAS char* sp_ = ((k2mask >> i) & 1u) ? kb2 + koff[i] : kb1 + koff[i]; \
            __builtin_amdgcn_global_load_lds((const GAS unsigned*)sp_, (LAS unsigned*)(Kw + n * 1024), 16, 0, 0); } \
        if (FOX) __builtin_amdgcn_global_load_lds((const GAS unsigned*)((const GAS float*)cum2 + 64 * j_ + lane), (LAS unsigned*)(Kw + 64 * KSTR), 4, 0, 0); } while (0)
#define ATT_DMAV(tt) do { const int t_ = (tt) < NTt ? (tt) : NTt - 1; LAS unsigned char* Vw = lds + 3 * KB + ((tt) & 1) * VB; const GAS char* vb_ = (const GAS char*)(Vp + (mk0 + 64 * (j0 + t_)) * vpitch); \
        _Pragma("unroll") for (int i = 0; i < NVD; ++i) { int n = w + 8 * i; if (n >= NIV) n -= 8; __builtin_amdgcn_global_load_lds((const GAS unsigned*)(vb_ + voff[i]), (LAS unsigned*)(Vw + n * 1024), 16, 0, 0); } } while (0)
#define ATT_WAITBAR(N) asm volatile("s_waitcnt vmcnt(%0) lgkmcnt(0)\n\ts_barrier" :: "n"(N) : "memory")
    const int NTt = NT - j0;
    f32x16 p0, p1;
#pragma unroll
    for (int r = 0; r < 16; ++r) { p0[r] = 0.f; p1[r] = 0.f; }
    asm volatile("s_waitcnt vmcnt(0) lgkmcnt(0)" ::: "memory"); __syncthreads();
    ATT_DMAK(0); ATT_DMAK(1); ATT_DMAV(0);
    ATT_WAITBAR(0);
    for (int tl = 0; tl < NTt; ++tl) { const int j = j0 + tl;
        ATT_DMAV(tl + 1); ATT_DMAK(tl + 2);
        if (j <= jlast) {
            const LAS unsigned char* Kt = lds + (tl % 3) * KB; const LAS float* cs = (const LAS float*)(Kt + 64 * KSTR);
            int ln1 = lane; asm volatile("" : "+v"(ln1));
            const LAS unsigned char* ka = Kt + (ln1 & 31) * KSTR + (ln1 >> 5) * 16;
            bf16x8 fa[2][4];
#define ATT_LOADP(bf_, pr_) do { fa[bf_][0] = *(const LAS bf16x8*)(ka + (2 * (pr_)) * 32); fa[bf_][1] = *(const LAS bf16x8*)(ka + 32 * KSTR + (2 * (pr_)) * 32); \
                                 fa[bf_][2] = *(const LAS bf16x8*)(ka + (2 * (pr_) + 1) * 32); fa[bf_][3] = *(const LAS bf16x8*)(ka + 32 * KSTR + (2 * (pr_) + 1) * 32); } while (0)
#define ATT_QV(ds_) (((ds_) < NQR) ? qf[(ds_) < NQR ? (ds_) : 0] : *(const LAS bf16x8*)(((ds_) - NQR < NPRING) ? qpark + ((ds_) - NQR) * 1024 : qpark2 + ((ds_) - NQR - NPRING) * 1024))
            ATT_LOADP(0, 0); ATT_LOADP(1, 1); __builtin_amdgcn_sched_barrier(0);
#pragma unroll
            for (int r = 0; r < 16; ++r) { p0[r] = 0.f; p1[r] = 0.f; }
#pragma unroll
            for (int pr = 0; pr < NDS / 2; ++pr) { const bf16x8 q0 = ATT_QV(2 * pr), q1 = ATT_QV(2 * pr + 1);
                p0 = MFMA32(fa[pr & 1][0], q0, p0); p1 = MFMA32(fa[pr & 1][1], q0, p1); p0 = MFMA32(fa[pr & 1][2], q1, p0); p1 = MFMA32(fa[pr & 1][3], q1, p1);
                __builtin_amdgcn_sched_barrier(0);
                if (pr + 2 < NDS / 2) { ATT_LOADP(pr & 1, pr + 2); __builtin_amdgcn_sched_barrier(0); } }
#undef ATT_LOADP
#undef ATT_QV
            if (FOX) {
#pragma unroll
                for (int g4 = 0; g4 < 4; ++g4) { const f32x4 c0 = *(const LAS f32x4*)(cs + 8 * g4 + 4 * hi), c1 = *(const LAS f32x4*)(cs + 32 + 8 * g4 + 4 * hi);
#pragma unroll
                    for (int e = 0; e < 4; ++e) { p0[4 * g4 + e] = __builtin_fmaf(p0[4 * g4 + e], c2, ct2 - c0[e]); p1[4 * g4 + e] = __builtin_fmaf(p1[4 * g4 + e], c2, ct2 - c1[e]); } }
            }
            {
            int ln2 = lane; asm volatile("" : "+v"(ln2));
            const LAS unsigned char* vbase = lds + 3 * KB + (tl & 1) * VB + (4 * (ln2 >> 5) + ((ln2 >> 2) & 3)) * VSTR + (16 * ((ln2 >> 4) & 1) + 4 * (ln2 & 3)) * 2;
            s16x4 fv[2][8];
#define ATT_LOADV(bf_, d0_) do { _Pragma("unroll") for (int s = 0; s < 4; ++s) { fv[bf_][2 * s] = vtr(vbase + (16 * s) * VSTR + (d0_) * 64); fv[bf_][2 * s + 1] = vtr(vbase + (16 * s + 8) * VSTR + (d0_) * 64); } } while (0)
            ATT_LOADV(0, 0); __builtin_amdgcn_sched_barrier(0);
            if (64 * j + 63 > qfirst) {
                const float NEG = -__builtin_inff();
                const int tq = qfirst + (ln2 & 31);
#pragma unroll
                for (int r = 0; r < 16; ++r) { const int key = 64 * j + crow(r, ln2 >> 5); if (key > tq) p0[r] = NEG; if (key + 32 > tq) p1[r] = NEG; }
            }
            float zmax = p0[0];
#pragma unroll
            for (int r = 1; r < 16; ++r) zmax = fmaxf(zmax, p0[r]);
#pragma unroll
            for (int r = 0; r < 16; ++r) zmax = fmaxf(zmax, p1[r]);
            zmax = fmaxf(zmax, __shfl_xor(zmax, 32));
            const float sc = FOX ? 1.0f : c2, zs = zmax * sc;
            const bool need = zs > m_run + 8.0f;
            const float alpha = need ? __builtin_amdgcn_exp2f(m_run - zs) : 1.0f; if (need) m_run = zs;
            const float nm = -m_run;
            float ps = 0.f;
#pragma unroll
            for (int r = 0; r < 16; ++r) { p0[r] = __builtin_amdgcn_exp2f(__builtin_fmaf(p0[r], sc, nm)); p1[r] = __builtin_amdgcn_exp2f(__builtin_fmaf(p1[r], sc, nm)); ps += p0[r] + p1[r]; }
            ps += __shfl_xor(ps, 32);
            l_run = l_run * alpha + ps;
            if (__any(need)) {
#pragma unroll
                for (int d0 = 0; d0 < 4; ++d0)
#pragma unroll
                    for (int r = 0; r < 16; ++r) o[d0][r] *= alpha; }
            bf16x8 pf[4]; pf[0] = packp8(p0, 0); pf[1] = packp8(p0, 1); pf[2] = packp8(p1, 0); pf[3] = packp8(p1, 1);
            __builtin_amdgcn_sched_barrier(0); ATT_LOADV(1, 1); __builtin_amdgcn_sched_barrier(0);
#pragma unroll
            for (int d0 = 0; d0 < 4; ++d0) {
#pragma unroll
                for (int s = 0; s < 4; ++s) o[d0] = MFMA32(cat44(fv[d0 & 1][2 * s], fv[d0 & 1][2 * s + 1]), pf[s], o[d0]);
                __builtin_amdgcn_sched_barrier(0);
                if (d0 + 2 < 4) { ATT_LOADV(d0 & 1, d0 + 2); __builtin_amdgcn_sched_barrier(0); } }
#undef ATT_LOADV
            }
        }
        ATT_WAITBAR(NKOPS);
    }
    asm volatile("s_waitcnt vmcnt(0)" ::: "memory");
#undef ATT_DMAK
#undef ATT_DMAV
#undef ATT_WAITBAR
    const float rl = 1.0f / l_run;
    bf16* orow = Op + ((size_t)b * SEQ + t) * opitch;
#pragma unroll
    for (int d0 = 0; d0 < 4; ++d0)
#pragma unroll
        for (int g4 = 0; g4 < 4; ++g4) { u32x2 wv; wv.x = pg8::cvt_pk_bf16(o[d0][4 * g4 + 0] * rl, o[d0][4 * g4 + 1] * rl); wv.y = pg8::cvt_pk_bf16(o[d0][4 * g4 + 2] * rl, o[d0][4 * g4 + 3] * rl);
            *(u32x2*)(orow + 32 * d0 + 8 * g4 + 4 * hi) = wv; }
    __syncthreads();
}

DEVI void ret_kv_unit(LAS unsigned char* lds, int bh, int c, const bf16* __restrict__ RK, const bf16* __restrict__ PROJ, float* __restrict__ KVC, float lg2) {
    constexpr int STR = 320;
    int tid_o = threadIdx.x; asm volatile("" : "+v"(tid_o));
    const int tid = tid_o, w = __builtin_amdgcn_readfirstlane(tid >> 6), lane = tid & 63, hi = lane >> 5;
    const int b = bh >> 3, h = bh & 7; const size_t m0 = (size_t)b * SEQ + (size_t)c * 128;
    LAS unsigned char* Kt = lds; LAS unsigned char* Vt = lds + 128 * STR;
    __syncthreads();
#pragma unroll
    for (int i = 0; i < 4; ++i) { const int ci = tid + 512 * i, row = ci >> 4, ch = ci & 15;
        const u32x4 kv = *(const u32x4*)(RK + (m0 + row) * 1024 + h * 128 + ch * 8); float f[8]; unpack8(kv, f); const float kd = __builtin_amdgcn_exp2f(lg2 * (float)(127 - row));
#pragma unroll
        for (int e = 0; e < 8; ++e) f[e] *= kd;
        *(LAS u32x4*)(Kt + row * STR + ch * 16) = pack8(f);
        *(LAS u32x4*)(Vt + row * STR + ch * 16) = *(const u32x4*)(PROJ + (m0 + row) * NINP + C_RV + h * 128 + ch * 8); }
    __syncthreads();
    const int eb = w & 3, dh = w >> 2, g = lane >> 4, q4 = (lane >> 2) & 3, p4 = lane & 3;
    const LAS unsigned char* abase = Vt + (4 * hi + q4) * STR + (32 * eb + 16 * (g & 1) + 4 * p4) * 2;
    const LAS unsigned char* bbase = Kt + (4 * hi + q4) * STR + (64 * dh + 16 * (g & 1) + 4 * p4) * 2;
    f32x16 acc[2];
#pragma unroll
    for (int r = 0; r < 16; ++r) { acc[0][r] = 0.f; acc[1][r] = 0.f; }
#pragma unroll
    for (int js = 0; js < 8; ++js) { const bf16x8 A = cat44(vtr(abase + (16 * js) * STR), vtr(abase + (16 * js + 8) * STR));
#pragma unroll
        for (int x = 0; x < 2; ++x) { const bf16x8 B = cat44(vtr(bbase + (16 * js) * STR + x * 64), vtr(bbase + (16 * js + 8) * STR + x * 64)); acc[x] = MFMA32(A, B, acc[x]); } }
    float* outp = KVC + ((size_t)(bh * 64 + c) * 128) * 128;
#pragma unroll
    for (int x = 0; x < 2; ++x)
#pragma unroll
        for (int r = 0; r < 16; ++r) outp[(size_t)(32 * eb + crow(r, hi)) * 128 + 64 * dh + 32 * x + (lane & 31)] = acc[x][r];
}

DEVI void ret_out_unit(LAS unsigned char* lds, int bh, int c, const bf16* __restrict__ RQ, const bf16* __restrict__ RK, const bf16* __restrict__ PROJ, const bf16* __restrict__ STB,
                       const float* __restrict__ gain, const float* __restrict__ bias, bf16* __restrict__ CAT, float lg2) {
    constexpr int KS = 272, VS = 320;
    int tid_o = threadIdx.x; asm volatile("" : "+v"(tid_o));
    const int tid = tid_o, w = __builtin_amdgcn_readfirstlane(tid >> 6), lane = tid & 63, r32 = lane & 31, hi = lane >> 5;
    const int b = bh >> 3, h = bh & 7; const size_t m0 = (size_t)b * SEQ + (size_t)c * 128;
    LAS unsigned char* Kt = lds; LAS unsigned char* Vt = lds + 128 * KS; LAS unsigned char* St = lds + 128 * KS + 128 * VS; LAS float* part = (LAS float*)(lds + 128 * KS + 128 * VS + 128 * KS);
    __syncthreads();
    const bf16* stsrc = STB + (size_t)(bh * 64 + c) * 16384;
#pragma unroll
    for (int i = 0; i < 4; ++i) { const int ci = tid + 512 * i, row = ci >> 4, ch = ci & 15;
        *(LAS u32x4*)(Kt + row * KS + ch * 16) = *(const u32x4*)(RK + (m0 + row) * 1024 + h * 128 + ch * 8);
        *(LAS u32x4*)(Vt + row * VS + ch * 16) = *(const u32x4*)(PROJ + (m0 + row) * NINP + C_RV + h * 128 + ch * 8);
        *(LAS u32x4*)(St + row * KS + ch * 16) = *(const u32x4*)(stsrc + row * 128 + ch * 8); }
    __syncthreads();
    const int ib = w & 3, eh = w >> 2, iloc = 32 * ib + r32; const size_t m = m0 + iloc;
    bf16x8 qf[8];
#pragma unroll
    for (int ds = 0; ds < 8; ++ds) qf[ds] = *(const bf16x8*)(RQ + m * 1024 + h * 128 + 16 * ds + 8 * hi);
    f32x16 o[2];
#pragma unroll
    for (int r = 0; r < 16; ++r) { o[0][r] = 0.f; o[1][r] = 0.f; }
    const int g = lane >> 4, q4 = (lane >> 2) & 3, p4 = lane & 3;
    const LAS unsigned char* vbase = Vt + (4 * hi + q4) * VS + (64 * eh + 16 * (g & 1) + 4 * p4) * 2;
    for (int jb = 0; jb <= ib; ++jb) {
        f32x16 p;
#pragma unroll
        for (int r = 0; r < 16; ++r) p[r] = 0.f;
        const LAS unsigned char* ka = Kt + (32 * jb + r32) * KS + hi * 16;
#pragma unroll
        for (int ds = 0; ds < 8; ++ds) p = MFMA32(*(const LAS bf16x8*)(ka + ds * 32), qf[ds], p);
#pragma unroll
        for (int r = 0; r < 16; ++r) { const int diff = iloc - (32 * jb + crow(r, hi)); p[r] = (diff >= 0) ? p[r] * __builtin_amdgcn_exp2f(lg2 * (float)diff) : 0.f; }
        const bf16x8 pf0 = packp8(p, 0), pf1 = packp8(p, 1);
        const LAS unsigned char* vb = vbase + (32 * jb) * VS;
#pragma unroll
        for (int x = 0; x < 2; ++x) {
            o[x] = MFMA32(cat44(vtr(vb + x * 64), vtr(vb + 8 * VS + x * 64)), pf0, o[x]);
            o[x] = MFMA32(cat44(vtr(vb + 16 * VS + x * 64), vtr(vb + 24 * VS + x * 64)), pf1, o[x]); }
    }
    {   f32x16 ca[2];
#pragma unroll
        for (int r = 0; r < 16; ++r) { ca[0][r] = 0.f; ca[1][r] = 0.f; }
        const LAS unsigned char* sa = St + (64 * eh + r32) * KS + hi * 16;
#pragma unroll
        for (int ds = 0; ds < 8; ++ds) { ca[0] = MFMA32(*(const LAS bf16x8*)(sa + ds * 32), qf[ds], ca[0]); ca[1] = MFMA32(*(const LAS bf16x8*)(sa + 32 * KS + ds * 32), qf[ds], ca[1]); }
        const float qd = __builtin_amdgcn_exp2f(lg2 * (float)(iloc + 1));
#pragma unroll
        for (int r = 0; r < 16; ++r) { o[0][r] += qd * ca[0][r]; o[1][r] += qd * ca[1][r]; } }
    float s1 = 0.f, s2 = 0.f;
#pragma unroll
    for (int r = 0; r < 16; ++r) { s1 += o[0][r] + o[1][r]; s2 += o[0][r] * o[0][r] + o[1][r] * o[1][r]; }
    s1 += __shfl_xor(s1, 32); s2 += __shfl_xor(s2, 32);
    if (hi == 0) { part[(eh * 128 + iloc) * 2] = s1; part[(eh * 128 + iloc) * 2 + 1] = s2; }
    __syncthreads();
    const float t1 = part[iloc * 2] + part[(128 + iloc) * 2], t2 = part[iloc * 2 + 1] + part[(128 + iloc) * 2 + 1];
    const float mu = t1 * (1.0f / 128.0f), var = fmaxf(t2 * (1.0f / 128.0f) - mu * mu, 0.f), rstd = 1.0f / sqrtf(var + LN_EPS);
    const bf16* grow = PROJ + m * NINP + C_RG + h * 128; bf16* orow = CAT + m * DM + h * 128;
#pragma unroll
    for (int x = 0; x < 2; ++x)
#pragma unroll
        for (int g4 = 0; g4 < 4; ++g4) { const int e0 = 64 * eh + 32 * x + 8 * g4 + 4 * hi;
            const f32x4 gn = *(const f32x4*)(gain + h * 128 + e0), bs = *(const f32x4*)(bias + h * 128 + e0); const u32x2 gw = *(const u32x2*)(grow + e0);
            const float gg[4] = {__uint_as_float(gw.x << 16), __uint_as_float(gw.x & 0xffff0000u), __uint_as_float(gw.y << 16), __uint_as_float(gw.y & 0xffff0000u)};
            float y[4];
#pragma unroll
            for (int e = 0; e < 4; ++e) y[e] = ((o[x][4 * g4 + e] - mu) * rstd * gn[e] + bs[e]) * (gg[e] * sigm(gg[e]));
            u32x2 wv; wv.x = pg8::cvt_pk_bf16(y[0], y[1]); wv.y = pg8::cvt_pk_bf16(y[2], y[3]); *(u32x2*)(orow + e0) = wv; }
}

struct Args { const void* in[35]; float* out; unsigned char* ws; int ph_lo, ph_hi; };
constexpr int NPH_LAYER = 16, NPHASES = 1 + DEPTH * NPH_LAYER;

__global__ void __launch_bounds__(NTHR, 2) fwd_kernel(Args args) {
    extern __shared__ __attribute__((aligned(16))) unsigned char lds_raw[];
    LAS unsigned char* lds = (LAS unsigned char*)lds_raw;
    const int G = gridDim.x, bid = blockIdx.x, NGW = G * NWAVES;
#define PHASE_IDS() int tid = threadIdx.x; asm volatile("" : "+v"(tid)); const int lane = tid & 63, wave = __builtin_amdgcn_readfirstlane(tid >> 6), gw = bid * NWAVES + wave; (void)lane; (void)gw
    volatile LAS unsigned* MISC = (volatile LAS unsigned*)(lds + LDSCTL_OFF);
    volatile LAS unsigned long long* TAB = (volatile LAS unsigned long long*)(lds + LDSCTL_OFF + 1024);
    { PHASE_IDS();
      for (int u = tid; u < (LDS_BYTES - LDSCTL_OFF) / 4; u += NTHR) ((LAS unsigned*)(lds + LDSCTL_OFF))[u] = 0u;
      __syncthreads();
      if (tid == 0) {
#define TSET(i) TAB[i] = (unsigned long long)args.in[i];
        TSET(0) TSET(1) TSET(2) TSET(3) TSET(4) TSET(5) TSET(6) TSET(7) TSET(8) TSET(9) TSET(10) TSET(11) TSET(12) TSET(13) TSET(14) TSET(15) TSET(16) TSET(17)
        TSET(18) TSET(19) TSET(20) TSET(21) TSET(22) TSET(23) TSET(24) TSET(25) TSET(26) TSET(27) TSET(28) TSET(29) TSET(30) TSET(31) TSET(32) TSET(33) TSET(34)
#undef TSET
        TAB[35] = (unsigned long long)args.out; TAB[36] = (unsigned long long)args.ws; }
      __syncthreads(); }
#define INP(i) ((const float*)rfl64(TAB[i]))
#define WSP(T, off) ((T*)((unsigned char*)rfl64(TAB[36]) + (off)))
#define HBUF() ((float*)rfl64(TAB[35]))
    XcdBarrier bar; bar.bar = (unsigned*)WSP(unsigned, WS_CTL + CW_BAR * 4); bar.x = 0; bar.st = nullptr;
    if (!MK_SPLIT) bar = xcd_barrier_post((unsigned*)WSP(unsigned, WS_CTL + CW_BAR * 4), MISC + 8);
    const int lo = args.ph_lo, hi_ph = args.ph_hi;
#define IN(k) (lo <= (k) && (k) < hi_ph)
#ifndef MK_MASK
#define MK_MASK 0xffff
#endif
#define EN(b) ((MK_MASK >> (b)) & 1)
#ifndef MK_DUP
#define MK_DUP 0
#endif
#define DUP(b) ((MK_DUP >> (b)) & 1)
#define SEAM(k) do { if (IN(k) && IN((k) + 1)) xcd_barrier(bar); } while (0)

    if (EN(0) && IN(0)) { PHASE_IDS();
        const int gt = bid * NTHR + tid, NGT = G * NTHR;
        const float* x = INP(0); const float* p_in = INP(1); const int* positions = (const int*)INP(2); float* hbuf = HBUF();
        float* COS128 = WSP(float, WS_COS128); float* SIN128 = WSP(float, WS_SIN128); float* COS64 = WSP(float, WS_COS64); float* SIN64 = WSP(float, WS_SIN64); bf16* P16 = WSP(bf16, WS_P16); float* RS = WSP(float, WS_RS);
        for (int idx = gt; idx < M * 64; idx += NGT) { const int m = idx >> 6, i = idx & 63; float s, c; sincos_d((float)positions[m] * inv_freq(i, 0.8659643233600653), s, c); COS128[idx] = c; SIN128[idx] = s; }
        for (int idx = gt; idx < M * 32; idx += NGT) { const int m = idx >> 5, i = idx & 31; float s, c; sincos_d((float)positions[m] * inv_freq(i, 0.7498942093324559), s, c); COS64[idx] = c; SIN64[idx] = s; }
        for (int idx = gt; idx < DEPTH * M * 256 / 4; idx += 4 * NGT) { f32x4 v[4];
#pragma unroll
            for (int u = 0; u < 4; ++u) v[u] = (idx + u * NGT < DEPTH * M * 256 / 4) ? ((const f32x4*)p_in)[idx + u * NGT] : (f32x4){0.f, 0.f, 0.f, 0.f};
#pragma unroll
            for (int u = 0; u < 4; ++u) if (idx + u * NGT < DEPTH * M * 256 / 4) { u32x2 o; o.x = pk2(v[u].x, v[u].y); o.y = pk2(v[u].z, v[u].w); ((u32x2*)P16)[idx + u * NGT] = o; } }
        const float* g0 = INP(3);
        bf16* H16 = WSP(bf16, WS_H16);
        for (int m = gw; m < M; m += NGW) norm_row<true, false, true>(x + (size_t)m * DM, H16 + (size_t)m * DM, nullptr, 0.f, g0, RS + m, lane);
    }

    for (int L = 0; L < DEPTH; ++L) {
        const int pb = 1 + L * NPH_LAYER;
        for (int rep_ = 0; rep_ < (DUP(1) ? 2 : 1); ++rep_) if (EN(1) && IN(pb + 0)) { PHASE_IDS();
            LAS float* scr = (LAS float*)(lds + wave * 16384);
            bf16* W_GU1 = WSP(bf16, WS_WGU1); bf16* W_GU2 = WSP(bf16, WS_WGU2); bf16* W_D1 = WSP(bf16, WS_WD1); bf16* W_D2 = WSP(bf16, WS_WD2); bf16* W_IN = WSP(bf16, WS_WIN); bf16* W_OUT = WSP(bf16, WS_WOUT);
            bf16* W_PG = WSP(bf16, WS_WPG); bf16* W_PP = WSP(bf16, WS_WPP); bf16* W_UQ = WSP(bf16, WS_WUQ); bf16* W_UKV = WSP(bf16, WS_WUKV); bf16* W_PW = WSP(bf16, WS_WPW);
            constexpr int I_F = 22016, I_IN = 64 * 344, I_SQ = 64 * 128, I_PP = 4 * 128, I_UQ = 16 * 48, I_UKV = 8 * 64, I_PW = 16 * 32;
            constexpr int NITEMS = 6 * I_F + I_IN + 2 * I_SQ + I_PP + I_UQ + I_UKV + I_PW;
            const size_t oF = (size_t)L * DM * DFF;
            for (int it = gw; it < NITEMS; it += NGW) {
                int r = it;
                if (r < 6 * I_F) { const int seg = r / I_F; r -= seg * I_F; const int f = seg / 3, kind = seg % 3;
                    const float* Wsrc = (const float*)(f ? (kind == 0 ? INP(27) : kind == 1 ? INP(28) : INP(29)) : (kind == 0 ? INP(4) : kind == 1 ? INP(5) : INP(6))) + oF;
                    if (kind < 2) { const int kb = r / 344, nb = r % 344, n0 = nb * 32; tr_item(Wsrc, DM, DFF, (f ? W_GU2 : W_GU1), (n0 >> 7) * 256 + (n0 & 127) + kind * 128, scr, kb * 64, n0, lane, (const float*)(f ? INP(26) : INP(3)) + (size_t)L * DM); }
                    else { const int kb = r / 128, nb = r % 128; tr_item(Wsrc, DFF, DM, (f ? W_D2 : W_D1), nb * 32, scr, kb * 64, nb * 32, lane); }
                    continue; }
                r -= 6 * I_F;
                if (r < I_IN) { const int kb = r / 344, nb = r % 344; tr_item(INP(9) + (size_t)L * DM * NIN, DM, NIN, W_IN, nb * 32, scr, kb * 64, nb * 32, lane, INP(8) + (size_t)L * DM); continue; } r -= I_IN;
                if (r < I_SQ) { const int kb = r / 128, nb = r % 128; tr_item(INP(24) + (size_t)L * DM * DM, DM, DM, W_OUT, nb * 32, scr, kb * 64, nb * 32, lane); continue; } r -= I_SQ;
                if (r < I_SQ) { const int kb = r / 128, nb = r % 128; tr_item(INP(32) + (size_t)L * DM * DM, DM, DM, W_PG, nb * 32, scr, kb * 64, nb * 32, lane, INP(31) + (size_t)L * DM); continue; } r -= I_SQ;
                if (r < I_PP) { const int kb = r / 128, nb = r % 128; tr_item(INP(33) + (size_t)L * 256 * DM, 256, DM, W_PP, nb * 32, scr, kb * 64, nb * 32, lane); continue; } r -= I_PP;
                if (r < I_UQ) { const int kb = r / 48, nb = r % 48; tr_item(INP(11) + (size_t)L * 1024 * 1536, 1024, 1536, W_UQ, nb * 32, scr, kb * 64, nb * 32, lane); continue; } r -= I_UQ;
                if (r < I_UKV) { const int kb = r / 64, nb = r % 64; tr_item(INP(13) + (size_t)L * 512 * 2048, 512, 2048, W_UKV, nb * 32, scr, kb * 64, nb * 32, lane); continue; } r -= I_UKV;
                { const int kb = r / 32, nb = r % 32; tr_item(INP(22) + (size_t)L * 1024 * 1024, 1024, 1024, W_PW, nb * 32, scr, kb * 64, nb * 32, lane); }
            }
        }
        SEAM(pb + 0);

        for (int half = 0; half < 2; ++half) {
            const int fa = pb + (half ? 11 : 1);
            for (int rep_ = 0; rep_ < (DUP(2) ? 2 : 1); ++rep_) if (EN(2) && IN(fa)) { PHASE_IDS(); pg8::Gemm g{WSP(bf16, WS_H16), half ? WSP(bf16, WS_WGU2) : WSP(bf16, WS_WGU1), M, 2 * DFF, DM}; pg8::StaticOrder S; S.init(M, 2 * DFF, G, bid, 8); pg8::EpiSwiglu E{WSP(bf16, WS_ACT), DFF, WSP(float, WS_RS)};
                pg8::gemm_phase<pg8::EpiSwiglu, pg8::StaticOrder, true, true>(lds, g, S, E);
                if (half == 0) { const int nshort = (5504 % G) ? G - (5504 % G) : G; const int first = G - nshort;
                    if (bid >= first) { pg8::Gemm g2{WSP(bf16, WS_P16) + (size_t)L * M * 256, WSP(bf16, WS_WPP), M, DM, 256}; pg8::StaticOrder S2; S2.init(M, DM, nshort, bid - first); pg8::EpiBf16P E2{WSP(bf16, WS_PPB), DM, nullptr, nullptr};
                        pg8::gemm_phase<pg8::EpiBf16P, pg8::StaticOrder, true, true>(lds, g2, S2, E2); } } }
            SEAM(fa);
            for (int rep_ = 0; rep_ < (DUP(3) ? 2 : 1); ++rep_) if (EN(3) && IN(fa + 1)) { PHASE_IDS(); pg8::Gemm g{WSP(bf16, WS_ACT), half ? WSP(bf16, WS_WD2) : WSP(bf16, WS_WD1), M, DM, DFF}; pg8::StaticOrder S; S.init(M, DM, G, bid); pg8::EpiBf16P E{WSP(bf16, WS_Y), DM, nullptr, nullptr};
                pg8::gemm_phase<pg8::EpiBf16P, pg8::StaticOrder, true, true>(lds, g, S, E); }
            SEAM(fa + 1);
            for (int rep_ = 0; rep_ < (DUP(4) ? 2 : 1); ++rep_) if (EN(4) && IN(fa + 2)) { PHASE_IDS(); float* hbuf = HBUF(); const bf16* Y = WSP(bf16, WS_Y); float* RS = WSP(float, WS_RS);
                const float* gpost = (const float*)(half ? INP(30) : INP(7)) + (size_t)L * DM; const float* gpre = (const float*)(half ? INP(31) : INP(8)) + (size_t)L * DM;
                bf16* H16 = WSP(bf16, WS_H16);
                { f32x4 gr[16];
_Pragma("unroll") for (int j = 0; j < 16; ++j) gr[j] = ((const f32x4*)gpost)[lane + 64 * j];
 for (int m = gw; m < M; m += NGW) norm_row<false, false, true, true>(H16 + (size_t)m * DM, H16 + (size_t)m * DM, Y + (size_t)m * DM, rep_ ? 0.f : 0.5f, gpost, RS + m, lane, gr); }
            }
            SEAM(fa + 2);

            if (half == 0) {
                for (int rep_ = 0; rep_ < (DUP(5) ? 2 : 1); ++rep_) if (EN(5) && IN(pb + 4)) { PHASE_IDS(); pg8::Gemm g{WSP(bf16, WS_H16), WSP(bf16, WS_WIN), M, NINP, DM}; pg8::StaticOrder S; S.init(M, NINP, G, bid); pg8::EpiBf16P E{WSP(bf16, WS_ACT), NINP, nullptr, WSP(float, WS_RS)};
                    pg8::gemm_phase<pg8::EpiBf16P, pg8::StaticOrder, true, true>(lds, g, S, E); }
                SEAM(pb + 4);
                for (int rep_ = 0; rep_ < (DUP(6) ? 2 : 1); ++rep_) if (EN(6) && IN(pb + 5)) { PHASE_IDS();
                    const bf16* PROJ = WSP(bf16, WS_ACT); const float* COS128 = WSP(float, WS_COS128); const float* SIN128 = WSP(float, WS_SIN128); const float* COS64 = WSP(float, WS_COS64); const float* SIN64 = WSP(float, WS_SIN64);
                    bf16* RQ = WSP(bf16, WS_RQ); bf16* RK = WSP(bf16, WS_RK); bf16* CQN = WSP(bf16, WS_CQN); bf16* CKVN = WSP(bf16, WS_CKVN); bf16* KR = WSP(bf16, WS_KR); float* LOGF = WSP(float, WS_LOGF); bf16* U = WSP(bf16, WS_U);
                    const float* qn = INP(10) + L * 1024; const float* kvn = INP(12) + L * 512; const float* fb = INP(16) + L * 8; const float* gb = INP(17) + L * 2048;
                    float mq0 = 0.f, mq1 = 0.f, mk0 = 0.f, mk1 = 0.f;
                    for (int m = gw; m < M; m += NGW) {
                        const bf16* pr = PROJ + (size_t)m * NINP; const int b = m >> 13, t = m & (SEQ - 1);
                        const int l16 = lane & 15, hq = lane >> 4;
                        u32x2 qa[2], qb[2], ka[2], kb[2];
#pragma unroll
                        for (int g = 0; g < 2; ++g) { const int ho = (4 * g + hq) * 128 + 4 * l16;
                            qa[g] = *(const u32x2*)(pr + C_RQ + ho); qb[g] = *(const u32x2*)(pr + C_RQ + ho + 64); ka[g] = *(const u32x2*)(pr + C_RK + ho); kb[g] = *(const u32x2*)(pr + C_RK + ho + 64); }
                        const f32x4 c4 = *(const f32x4*)(COS128 + m * 64 + 4 * l16), s4 = *(const f32x4*)(SIN128 + m * 64 + 4 * l16);
                        const u32x4 cq0 = *(const u32x4*)(pr + C_CQ + lane * 8), cq1 = *(const u32x4*)(pr + C_CQ + 512 + lane * 8), ckv = *(const u32x4*)(pr + C_CKV + lane * 8);
                        const u32x4 fq0 = *(const u32x4*)(pr + C_FQ + lane * 16), fq1 = *(const u32x4*)(pr + C_FQ + lane * 16 + 8), fk0 = *(const u32x4*)(pr + C_FK + lane * 16), fk1 = *(const u32x4*)(pr + C_FK + lane * 16 + 8);
                        const u32x4 ca0 = *(const u32x4*)(pr + C_CIN + lane * 8), ca1 = *(const u32x4*)(pr + C_CIN + 512 + lane * 8), cg0 = *(const u32x4*)(pr + C_CIN + 1024 + lane * 8), cg1 = *(const u32x4*)(pr + C_CIN + 1536 + lane * 8);
                        float c64 = 0.f, s64 = 0.f; unsigned short kr1 = 0, kr2 = 0, ffr = 0;
                        if (lane < 32) { c64 = COS64[m * 32 + lane]; s64 = SIN64[m * 32 + lane]; kr1 = pr[C_KR + lane]; kr2 = pr[C_KR + 32 + lane]; }
                        if (lane < 8) ffr = pr[C_FF + lane];
                        {
#pragma unroll
                          for (int g = 0; g < 2; ++g) { const size_t oo = (size_t)m * 1024 + (4 * g + hq) * 128 + 4 * l16;
                              const f32x4 q1 = {__uint_as_float(qa[g].x << 16), __uint_as_float(qa[g].x & 0xffff0000u), __uint_as_float(qa[g].y << 16), __uint_as_float(qa[g].y & 0xffff0000u)};
                              const f32x4 q2 = {__uint_as_float(qb[g].x << 16), __uint_as_float(qb[g].x & 0xffff0000u), __uint_as_float(qb[g].y << 16), __uint_as_float(qb[g].y & 0xffff0000u)};
                              const f32x4 k1 = {__uint_as_float(ka[g].x << 16), __uint_as_float(ka[g].x & 0xffff0000u), __uint_as_float(ka[g].y << 16), __uint_as_float(ka[g].y & 0xffff0000u)};
                              const f32x4 k2 = {__uint_as_float(kb[g].x << 16), __uint_as_float(kb[g].x & 0xffff0000u), __uint_as_float(kb[g].y << 16), __uint_as_float(kb[g].y & 0xffff0000u)};
                              const f32x4 qo1 = q1 * c4 - q2 * s4, qo2 = q2 * c4 + q1 * s4, ko1 = (k1 * c4 - k2 * s4) * 0.08838834764831845f, ko2 = (k2 * c4 + k1 * s4) * 0.08838834764831845f;
                              u32x2 w; w.x = pk2(qo1.x, qo1.y); w.y = pk2(qo1.z, qo1.w); *(u32x2*)(RQ + oo) = w; w.x = pk2(qo2.x, qo2.y); w.y = pk2(qo2.z, qo2.w); *(u32x2*)(RQ + oo + 64) = w;
                              w.x = pk2(ko1.x, ko1.y); w.y = pk2(ko1.z, ko1.w); *(u32x2*)(RK + oo) = w; w.x = pk2(ko2.x, ko2.y); w.y = pk2(ko2.z, ko2.w); *(u32x2*)(RK + oo + 64) = w; } }
                        { float f0[8], f1[8]; unpack8(cq0, f0); unpack8(cq1, f1); float ss = 0.f;
#pragma unroll
                          for (int e = 0; e < 8; ++e) ss += f0[e] * f0[e] + f1[e] * f1[e];
                          const float rs = 1.0f / sqrtf(wave_sum(ss) * (1.0f / 1024.0f) + NORM_EPS);
#pragma unroll
                          for (int e = 0; e < 8; ++e) { f0[e] *= rs * qn[lane * 8 + e]; f1[e] *= rs * qn[512 + lane * 8 + e]; }
                          *(u32x4*)(CQN + (size_t)m * 1024 + lane * 8) = pack8(f0); *(u32x4*)(CQN + (size_t)m * 1024 + 512 + lane * 8) = pack8(f1); }
                        { float f0[8]; unpack8(ckv, f0); float ss = 0.f;
#pragma unroll
                          for (int e = 0; e < 8; ++e) ss += f0[e] * f0[e];
                          const float rs = 1.0f / sqrtf(wave_sum(ss) * (1.0f / 512.0f) + NORM_EPS);
#pragma unroll
                          for (int e = 0; e < 8; ++e) f0[e] *= rs * kvn[lane * 8 + e];
                          *(u32x4*)(CKVN + (size_t)m * 512 + lane * 8) = pack8(f0); }
                        if (lane < 32) { const float x1 = bf2f(kr1), x2 = bf2f(kr2);
                            KR[(size_t)m * 64 + lane] = (bf16)f2bf(x1 * c64 - x2 * s64); KR[(size_t)m * 64 + 32 + lane] = (bf16)f2bf(x2 * c64 + x1 * s64); }
                        { float fq[8], fk[8]; float sq = 0.f, sk = 0.f;
                          unpack8(fq0, fq); unpack8(fk0, fk);
#pragma unroll
                          for (int e = 0; e < 8; ++e) { sq += fq[e] * fq[e]; sk += fk[e] * fk[e]; }
                          unpack8(fq1, fq); unpack8(fk1, fk);
#pragma unroll
                          for (int e = 0; e < 8; ++e) { sq += fq[e] * fq[e]; sk += fk[e] * fk[e]; }
                          sq += __shfl_xor(sq, 1); sq += __shfl_xor(sq, 2); sq += __shfl_xor(sq, 4); sk += __shfl_xor(sk, 1); sk += __shfl_xor(sk, 2); sk += __shfl_xor(sk, 4);
                          if (b) { mq1 = fmaxf(mq1, sq); mk1 = fmaxf(mk1, sk); } else { mq0 = fmaxf(mq0, sq); mk0 = fmaxf(mk0, sk); } }
                        if (lane < 8) { const float xv = bf2f(ffr) + fb[lane]; LOGF[(size_t)(b * 8 + lane) * SEQ + t] = fminf(xv, 0.f) - __logf(1.0f + __expf(-fabsf(xv))); }
                        {
#pragma unroll
                          for (int hf = 0; hf < 2; ++hf) { const int c0 = hf * 512 + lane * 8; float a[8], gt_[8]; unpack8(hf ? ca1 : ca0, a); unpack8(hf ? cg1 : cg0, gt_);
#pragma unroll
                              for (int e = 0; e < 8; ++e) a[e] = (a[e] + gb[c0 + e]) * sigm(gt_[e] + gb[1024 + c0 + e]);
                              *(u32x4*)(U + (size_t)m * 1024 + c0) = pack8(a); } }
                    }
                    {
                        LAS float* part = (LAS float*)lds;
                        if ((lane & 7) == 0) { const int h = lane >> 3; LAS float* pw = part + wave * 32; pw[(0 * 8 + h) * 2] = mq0; pw[(0 * 8 + h) * 2 + 1] = mk0; pw[(1 * 8 + h) * 2] = mq1; pw[(1 * 8 + h) * 2 + 1] = mk1; }
                        __syncthreads();
                        if (tid < 32) { float v = part[tid];
#pragma unroll
                            for (int ww = 1; ww < 8; ++ww) v = fmaxf(v, part[ww * 32 + tid]);
                            WSP(float, WS_CTL + CW_QK * 4)[(size_t)L * 32768 + bid * 32 + tid] = v; }
                        __syncthreads(); }
                }
                SEAM(pb + 5);
                for (int rep_ = 0; rep_ < (DUP(7) ? 2 : 1); ++rep_) if (EN(7) && IN(pb + 6)) { PHASE_IDS();
                    const float* LOGF = WSP(float, WS_LOGF); float* CUM2 = WSP(float, WS_CUM2);
                    if (bid < 16) {
                        LAS double* sc = (LAS double*)lds;
                        const float* src = LOGF + (size_t)bid * SEQ + tid * 16; float v[16];
#pragma unroll
                        for (int e = 0; e < 4; ++e) { const f32x4 q = ((const f32x4*)src)[e]; v[4 * e] = q.x; v[4 * e + 1] = q.y; v[4 * e + 2] = q.z; v[4 * e + 3] = q.w; }
                        double tot = 0.0;
#pragma unroll
                        for (int e = 0; e < 16; ++e) tot += (double)v[e];
                        double inc = tot;
#pragma unroll
                        for (int o = 1; o < 64; o <<= 1) { const double nb = __shfl_up(inc, o); if (lane >= o) inc += nb; }
                        if (lane == 63) sc[wave] = inc;
                        __syncthreads();
                        double base = inc - tot;
                        for (int ww = 0; ww < wave; ++ww) base += sc[ww];
                        float* dst = CUM2 + (size_t)bid * SEQ + tid * 16;
#pragma unroll
                        for (int e = 0; e < 16; ++e) { base += (double)v[e]; dst[e] = (float)(base * 1.4426950408889634074); }
                        __syncthreads();
                    }
                    { pg8::Gemm g{WSP(bf16, WS_CQN), WSP(bf16, WS_WUQ), M, 1536, 1024}; pg8::StaticOrder S; S.init(M, 1536, G, bid); pg8::EpiBf16P E{WSP(bf16, WS_MQ), 1536, nullptr, nullptr};
                      pg8::gemm_phase<pg8::EpiBf16P, pg8::StaticOrder, true, true>(lds, g, S, E); }
                    { pg8::Gemm g{WSP(bf16, WS_CKVN), WSP(bf16, WS_WUKV), M, 2048, 512}; pg8::StaticOrder S; S.init(M, 2048, G, bid); pg8::EpiBf16P E{WSP(bf16, WS_KVR), 2048, nullptr, nullptr};
                      pg8::gemm_phase<pg8::EpiBf16P, pg8::StaticOrder, true, true>(lds, g, S, E); }
                    {
                        const bf16* U = WSP(bf16, WS_U); bf16* YC = WSP(bf16, WS_YC);
                        const float* dw = INP(18) + (size_t)L * 31 * 1024; const float* dwb = INP(19) + L * 1024;
                        const float* lng = INP(20) + L * 1024; const float* lnb = INP(21) + L * 1024;
                        for (int grp = gw; grp < M / 4; grp += NGW) { const int m0 = grp * 4, t0 = m0 & (SEQ - 1);
                            float acc[4][16]; f32x4 wt[4][4];
#pragma unroll
                            for (int o = 0; o < 4; ++o)
#pragma unroll
                                for (int e = 0; e < 16; ++e) acc[o][e] = 0.f;
#pragma unroll
                            for (int s = 0; s < 4; ++s)
#pragma unroll
                                for (int q = 0; q < 4; ++q) wt[s][q] = (f32x4){0.f, 0.f, 0.f, 0.f};
#pragma unroll 1
                            for (int qq = 0; qq < 9; ++qq) {
#pragma unroll
                                for (int s = 0; s < 4; ++s) { const int ri = 4 * qq + s;
                                    if (s & 1) asm volatile("" ::: "memory");
                                    if (ri <= 33) {
                                        if (ri <= 30) {
#pragma unroll
                                            for (int hf = 0; hf < 2; ++hf) { wt[s][2 * hf] = *(const f32x4*)(dw + ri * 1024 + hf * 512 + lane * 8); wt[s][2 * hf + 1] = *(const f32x4*)(dw + ri * 1024 + hf * 512 + lane * 8 + 4); } }
                                        const int tt = t0 - 30 + ri;
                                        if (tt >= 0) { float ua[8], ub[8]; const bf16* ur = U + (size_t)(m0 - 30 + ri) * 1024;
                                            unpack8(*(const u32x4*)(ur + lane * 8), ua); unpack8(*(const u32x4*)(ur + 512 + lane * 8), ub);
#pragma unroll
                                            for (int o = 0; o < 4; ++o) { const int j = ri - o;
                                                if (j >= 0 && j <= 30) { const int ws = (s - o) & 3;
#pragma unroll
                                                    for (int e = 0; e < 4; ++e) { acc[o][e] += ua[e] * wt[ws][0][e]; acc[o][4 + e] += ua[4 + e] * wt[ws][1][e]; acc[o][8 + e] += ub[e] * wt[ws][2][e]; acc[o][12 + e] += ub[4 + e] * wt[ws][3][e]; } } } } } } }
#pragma unroll
                            for (int o = 0; o < 4; ++o) { const int m = m0 + o; float s1 = 0.f;
#pragma unroll
                                for (int hf = 0; hf < 2; ++hf)
#pragma unroll
                                    for (int e = 0; e < 8; ++e) { acc[o][hf * 8 + e] += dwb[hf * 512 + lane * 8 + e]; s1 += acc[o][hf * 8 + e]; }
                                const float mu = wave_sum(s1) * (1.0f / 1024.0f); float s2 = 0.f;
#pragma unroll
                                for (int e = 0; e < 16; ++e) { acc[o][e] -= mu; s2 += acc[o][e] * acc[o][e]; }
                                const float rstd = 1.0f / sqrtf(wave_sum(s2) * (1.0f / 1024.0f) + LN_EPS);
#pragma unroll
                                for (int hf = 0; hf < 2; ++hf) { const int c0 = hf * 512 + lane * 8; float o8[8];
#pragma unroll
                                    for (int e = 0; e < 8; ++e) { const float yv = acc[o][hf * 8 + e] * rstd * lng[c0 + e] + lnb[c0 + e]; o8[e] = yv * sigm(yv); }
                                    *(u32x4*)(YC + (size_t)m * 1024 + c0) = pack8(o8); } } }
                    }
                    asm volatile("s_waitcnt vmcnt(0)" ::: "memory");
                    { const bf16* RK = WSP(bf16, WS_RK); const bf16* PROJ = WSP(bf16, WS_ACT); float* KVC = WSP(float, WS_KVC);
                      for (int u = bid; u < 1024; u += G) { const int bh = u >> 6, c = u & 63; ret_kv_unit(lds, bh, c, RK, PROJ, KVC, ret_lg2(bh & 7)); } }
                    __syncthreads();
                }
                SEAM(pb + 6);
                if (EN(8) && IN(pb + 7)) { PHASE_IDS();
                    { pg8::Gemm g{WSP(bf16, WS_YC), WSP(bf16, WS_WPW), M, 1024, 1024}; pg8::StaticOrder S; S.init(M, 1024, G, bid); pg8::EpiBf16P E{WSP(bf16, WS_CAT) + 3072, DM, INP(23) + L * 1024, nullptr};
                      pg8::gemm_phase<pg8::EpiBf16P, pg8::StaticOrder, true, true>(lds, g, S, E); }
                    bf16* MQ = WSP(bf16, WS_MQ); const float* COS64 = WSP(float, WS_COS64); const float* SIN64 = WSP(float, WS_SIN64); const float* KVC = WSP(float, WS_KVC); bf16* STB = WSP(bf16, WS_ST);
                    for (int m = gw; m < M; m += NGW) { const int hh = lane >> 3, i4 = (lane & 7) * 4; bf16* qp = MQ + (size_t)m * 1536 + hh * 192 + 128 + i4;
                        const u32x2 xa = *(const u32x2*)qp, xb = *(const u32x2*)(qp + 32); const f32x4 cc = *(const f32x4*)(COS64 + m * 32 + i4), sn = *(const f32x4*)(SIN64 + m * 32 + i4);
                        const f32x4 x1 = {__uint_as_float(xa.x << 16), __uint_as_float(xa.x & 0xffff0000u), __uint_as_float(xa.y << 16), __uint_as_float(xa.y & 0xffff0000u)};
                        const f32x4 x2 = {__uint_as_float(xb.x << 16), __uint_as_float(xb.x & 0xffff0000u), __uint_as_float(xb.y << 16), __uint_as_float(xb.y & 0xffff0000u)};
                        const f32x4 o1 = x1 * cc - x2 * sn, o2 = x2 * cc + x1 * sn;
                        u32x2 w; w.x = pk2(o1.x, o1.y); w.y = pk2(o1.z, o1.w); *(u32x2*)qp = w; w.x = pk2(o2.x, o2.y); w.y = pk2(o2.z, o2.w); *(u32x2*)(qp + 32) = w; }
                    for (int idx = bid * NTHR + tid; idx < 16 * 8192; idx += G * NTHR) { const int bh = idx >> 13, ed = (idx & 8191) * 2; const float cd = __builtin_amdgcn_exp2f(ret_lg2(bh & 7) * 128.0f);
                        const float* kp = KVC + (size_t)bh * 64 * 16384 + ed; bf16* sp = STB + (size_t)bh * 64 * 16384 + ed; float S0 = 0.f, S1 = 0.f;
                        for (int cb = 0; cb < 64; cb += 16) { float kv0[16], kv1[16];
#pragma unroll
                            for (int c = 0; c < 16; ++c) { kv0[c] = kp[(size_t)(cb + c) * 16384]; kv1[c] = kp[(size_t)(cb + c) * 16384 + 1]; }
#pragma unroll
                            for (int c = 0; c < 16; ++c) { *(unsigned*)(sp + (size_t)(cb + c) * 16384) = pk2(S0, S1); S0 = S0 * cd + kv0[c]; S1 = S1 * cd + kv1[c]; } } }
                }
                SEAM(pb + 7);
                for (int rep_ = 0; rep_ < (DUP(9) ? 2 : 1); ++rep_) if (EN(9) && IN(pb + 8)) { PHASE_IDS();
                    asm volatile("s_waitcnt vmcnt(0)" ::: "memory"); __syncthreads();
                    const bf16* MQ = WSP(bf16, WS_MQ); const bf16* KVR = WSP(bf16, WS_KVR); const bf16* KR = WSP(bf16, WS_KR); const bf16* PROJ = WSP(bf16, WS_ACT); const float* CUM2 = WSP(float, WS_CUM2); bf16* CAT = WSP(bf16, WS_CAT);
                    const bf16* RQ = WSP(bf16, WS_RQ); const bf16* RK = WSP(bf16, WS_RK); const bf16* STB = WSP(bf16, WS_ST); const float* QKP = WSP(float, WS_CTL + CW_QK * 4) + (size_t)L * 32768;
                    for (int k = bid; k < 512; k += G) { const int i = (k < 256) ? k : 767 - k; const int qb = 31 - (i >> 4), bh = i & 15, b = bh >> 3, h = bh & 7;
                        attn_unit<192, false>(lds, b, qb, MQ + h * 192, 1536, KVR + h * 256, 2048, KR, 64, KVR + h * 256 + 128, 2048, nullptr, CAT + 1024 + h * 128, DM, 0.07216878364870323f * LOG2E, 0.f); }
                    for (int k = bid; k < 512; k += G) { const int i = (k < 256) ? k : 767 - k; const int qb = 31 - (i >> 4), bh = i & 15, b = bh >> 3, h = bh & 7;
                        float mq = 0.f, mk = 0.f; int ln_ = threadIdx.x; asm volatile("" : "+v"(ln_)); for (int blk = ln_ & 63; blk < G; blk += 64) { mq = fmaxf(mq, QKP[blk * 32 + bh * 2]); mk = fmaxf(mk, QKP[blk * 32 + bh * 2 + 1]); }
                        mq = wave_max(mq); mk = wave_max(mk);
                        const float qkm = sqrtf(mq * mk) * (0.08838834764831845f * LOG2E);
                        attn_unit<128, true>(lds, b, qb, PROJ + C_FQ + h * 128, NINP, PROJ + C_FK + h * 128, NINP, nullptr, 0, PROJ + C_FV + h * 128, NINP, CUM2 + (size_t)bh * SEQ, CAT + 2048 + h * 128, DM, 0.08838834764831845f * LOG2E, qkm); }
                    const float* gg = INP(14) + L * 1024; const float* gbias = INP(15) + L * 1024;
                    for (int u = bid; u < 1024; u += G) { const int bh = u >> 6, c = u & 63; ret_out_unit(lds, bh, c, RQ, RK, PROJ, STB, gg, gbias, CAT, ret_lg2(bh & 7)); }
                    __syncthreads();
                }
                SEAM(pb + 8);
                for (int rep_ = 0; rep_ < (DUP(10) ? 2 : 1); ++rep_) if (EN(10) && IN(pb + 9)) { PHASE_IDS(); pg8::Gemm g{WSP(bf16, WS_CAT), WSP(bf16, WS_WOUT), M, DM, DM}; pg8::StaticOrder S; S.init(M, DM, G, bid); pg8::EpiBf16P E{WSP(bf16, WS_Y), DM, nullptr, nullptr};
                    pg8::gemm_phase<pg8::EpiBf16P, pg8::StaticOrder, true, true>(lds, g, S, E); }
                SEAM(pb + 9);
                for (int rep_ = 0; rep_ < (DUP(11) ? 2 : 1); ++rep_) if (EN(11) && IN(pb + 10)) { PHASE_IDS(); float* hbuf = HBUF(); const bf16* Y = WSP(bf16, WS_Y); float* RS = WSP(float, WS_RS); const float* gpost = INP(25) + (size_t)L * DM; const float* gpre = INP(26) + (size_t)L * DM;
                    bf16* H16 = WSP(bf16, WS_H16);
                    { f32x4 gr[16];
_Pragma("unroll") for (int j = 0; j < 16; ++j) gr[j] = ((const f32x4*)gpost)[lane + 64 * j];
 for (int m = gw; m < M; m += NGW) norm_row<false, false, true, true>(H16 + (size_t)m * DM, H16 + (size_t)m * DM, Y + (size_t)m * DM, rep_ ? 0.f : 1.0f, gpost, RS + m, lane, gr); } }
                SEAM(pb + 10);
            } else {
                for (int rep_ = 0; rep_ < (DUP(12) ? 2 : 1); ++rep_) if (EN(12) && IN(pb + 14)) { PHASE_IDS(); pg8::Gemm g{WSP(bf16, WS_H16), WSP(bf16, WS_WPG), M, DM, DM}; pg8::StaticOrder S; S.init(M, DM, G, bid); pg8::EpiPle E{WSP(bf16, WS_Y), WSP(bf16, WS_PPB), DM, WSP(float, WS_RS)};
                    pg8::gemm_phase<pg8::EpiPle, pg8::StaticOrder, true, true>(lds, g, S, E); }
                SEAM(pb + 14);
                for (int rep_ = 0; rep_ < (DUP(13) ? 2 : 1); ++rep_) if (EN(13) && IN(pb + 15)) { PHASE_IDS(); float* hbuf = HBUF(); const bf16* Y = WSP(bf16, WS_Y); float* RS = WSP(float, WS_RS); bf16* H16 = WSP(bf16, WS_H16); const float* gpost = INP(34) + (size_t)L * DM;
                    if (L + 1 < DEPTH) { const float* gpre = INP(3) + (size_t)(L + 1) * DM;
                        { f32x4 gr[16];
_Pragma("unroll") for (int j = 0; j < 16; ++j) gr[j] = ((const f32x4*)gpost)[lane + 64 * j];
 for (int m = gw; m < M; m += NGW) norm_row<false, false, true, true>(H16 + (size_t)m * DM, H16 + (size_t)m * DM, Y + (size_t)m * DM, rep_ ? 0.f : 1.0f, gpost, RS + m, lane, gr); } }
                    else { { f32x4 gr[16];
_Pragma("unroll") for (int j = 0; j < 16; ++j) gr[j] = ((const f32x4*)gpost)[lane + 64 * j];
 for (int m = gw; m < M; m += NGW) norm_row<false, true, false, true>(H16 + (size_t)m * DM, hbuf + (size_t)m * DM, Y + (size_t)m * DM, rep_ ? 0.f : 1.0f, gpost, nullptr, lane, gr); } } }
            }
        }
    }
#undef IN
#undef SEAM
}

extern "C" void kernel_launch(void* const* d_in, const int* in_sizes, int n_in, void* d_out, int out_size, void* d_ws, size_t ws_size, hipStream_t stream) {
    static int grid = 0;
    if (grid == 0) {
        if (n_in != 35 || out_size != M * DM || ws_size < WS_END) { fprintf(stderr, "kernel_launch: unexpected shapes (n_in %d, out %d, ws %zu < %zu)\n", n_in, out_size, ws_size, (size_t)WS_END); grid = -1; return; }
        int dev = 0, cus = 0, per_cu = 0;
        if (hipGetDevice(&dev) != hipSuccess || hipDeviceGetAttribute(&cus, hipDeviceAttributeMultiprocessorCount, dev) != hipSuccess) { grid = -1; return; }
        if (hipFuncSetAttribute((const void*)fwd_kernel, hipFuncAttributeMaxDynamicSharedMemorySize, LDS_BYTES) != hipSuccess) { fprintf(stderr, "kernel_launch: hipFuncSetAttribute failed\n"); grid = -1; return; }
        if (hipOccupancyMaxActiveBlocksPerMultiprocessor(&per_cu, (const void*)fwd_kernel, NTHR, LDS_BYTES) != hipSuccess || per_cu < 1) fprintf(stderr, "kernel_launch: occupancy query says %d\n", per_cu);
        (void)hipGetLastError();
        grid = cus;
    }
    if (grid < 0) return;
    (void)hipMemsetAsync((char*)d_ws + WS_CTL, 0, CTL_ZERO_BYTES, stream);
    Args a; memset(&a, 0, sizeof(a));
    for (int i = 0; i < 35; ++i) a.in[i] = d_in[i];
    a.out = (float*)d_out; a.ws = (unsigned char*)d_ws;
#if MK_SPLIT
    for (int ph = 0; ph < NPHASES; ++ph) { a.ph_lo = ph; a.ph_hi = ph + 1; hipLaunchKernelGGL(fwd_kernel, dim3(grid), dim3(NTHR), LDS_BYTES, stream, a); }
#else
    a.ph_lo = 0; a.ph_hi = NPHASES; hipLaunchKernelGGL(fwd_kernel, dim3(grid), dim3(NTHR), LDS_BYTES, stream, a);
#endif
}
```

```cpp
#include <hip/hip_runtime.h>
#include <cstdio>
#include <cstdint>
#include <cstring>
#include <cmath>
namespace pg8 {
#define PG8_LAS __attribute__((address_space(3)))
typedef unsigned short bf16_t;
typedef short bf16x8 __attribute__((ext_vector_type(8)));
typedef float f32x4 __attribute__((ext_vector_type(4)));
typedef unsigned u32x4 __attribute__((ext_vector_type(4)));
constexpr int BM = 256, BK = 64, HALF = 128, HTB = HALF * BK * 2  , STAGE_BYTES = 8 * HTB, NXCD = 8, WGM = 8;

__host__ __device__ __forceinline__ int lds_byte(int r, int c) { const int st = (r >> 4) * 2 + (c >> 5), rr = r & 15, cc = c & 31, ob = rr * 64 + cc * 2; return st * 1024 + (ob ^ (((ob >> 9) & 1) << 5)); }
__host__ __device__ __forceinline__ void stage_rc(int b, int& R, int& C) { const int st = b / 1024, sb = b % 1024, swz = sb ^ (((sb >> 9) & 1) << 5); R = (st >> 1) * 16 + swz / 64; C = (st & 1) * 32 + (swz % 64) / 2; }
__host__ __device__ __forceinline__ int perm32(int rho) { const int n = rho >> 4, i = rho & 15; return 8 * (i >> 2) + 4 * n + (i & 3); }

struct Unit { int pm, pn; };
struct Gemm { const bf16_t* A; const bf16_t* Bt; int M, N, K; };

struct StaticOrder {
    int nM, nN, nwg, G, c, wgm;
    __host__ __device__ void init(int M, int N, int G_, int c_, int wgm_ = 4) { nM = M / BM; nN = N / BM; nwg = nM * nN; G = G_; c = c_; wgm = wgm_; }
    __host__ __device__ bool next(int i, Unit& u) const {
        const long L = (long)i * G + c; if (L >= nwg) return false;
        int wgid = (int)L; { const int q = nwg / NXCD, r = nwg % NXCD, xcd = wgid % NXCD, off = wgid / NXCD; wgid = (xcd < r ? xcd * (q + 1) : r * (q + 1) + (xcd - r) * q) + off; }
        const int nig = wgm * nN, gid = wgid / nig, fm = gid * wgm, gsz = (nM - fm) < wgm ? (nM - fm) : wgm;
        u.pm = fm + ((wgid % nig) % gsz); u.pn = (wgid % nig) / gsz; return true;
    }
    __device__ __forceinline__ void a_ready(const Unit&) const {}
    __device__ __forceinline__ void done(const Unit&) const {}
};

__device__ __forceinline__ unsigned cvt_pk_bf16(float lo, float hi) { unsigned r; asm volatile("v_cvt_pk_bf16_f32 %0, %1, %2" : "=v"(r) : "v"(lo), "v"(hi)); return r; }
__device__ __forceinline__ float sigm(float x) { return __builtin_amdgcn_rcpf(1.0f + __builtin_amdgcn_exp2f(-1.4426950408889634f * x)); }
typedef unsigned u32x2 __attribute__((ext_vector_type(2)));
#define PG8_GAS __attribute__((address_space(1)))

struct EpiF32 {
    static constexpr bool PERM = false, AFTER_DRAIN = false;
    float* C; int ldc;
    __device__ __forceinline__ void pre(const Unit&, int, int, float (&)[8]) const {}
    __device__ __forceinline__ void operator()(const f32x4 (&acc)[2][2][4][2], const Unit& u, int wr, int wc, int fr, int fq, const float (&)[8]) const {
        const int row0 = u.pm * BM + wr * 64 + fr, col0 = u.pn * BM + wc * 32 + 4 * fq;
#pragma unroll
        for (int ai = 0; ai < 2; ++ai)
#pragma unroll
            for (int m = 0; m < 4; ++m) { float* rowp = C + (size_t)(row0 + ai * HALF + m * 16) * ldc + col0;
#pragma unroll
                for (int bj = 0; bj < 2; ++bj)
#pragma unroll
                    for (int n = 0; n < 2; ++n) *(PG8_GAS f32x4*)(rowp + bj * HALF + n * 16) = acc[ai][bj][m][n]; }
    }
};
struct EpiBf16P {
    static constexpr bool PERM = true, AFTER_DRAIN = false;
    bf16_t* O; int ldc; const float* bias; const float* rsc;
    __device__ __forceinline__ void pre(const Unit& u, int wr, int fr, float (&rsp)[8]) const { const int row0 = u.pm * BM + wr * 64 + fr;
#pragma unroll
        for (int i = 0; i < 8; ++i) rsp[i] = rsc ? ((const PG8_GAS float*)rsc)[row0 + (i >> 2) * HALF + (i & 3) * 16] : 1.0f; }
    __device__ __forceinline__ void operator()(const f32x4 (&acc)[2][2][4][2], const Unit& u, int wr, int wc, int fr, int fq, const float (&rsp)[8]) const {
        const int row0 = u.pm * BM + wr * 64 + fr; const int col0 = u.pn * BM + wc * 32 + 8 * fq;
        float rs[2][4];
#pragma unroll
        for (int ai = 0; ai < 2; ++ai)
#pragma unroll
            for (int m = 0; m < 4; ++m) rs[ai][m] = rsp[ai * 4 + m];
        f32x4 bv[2][2];
#pragma unroll
        for (int bj = 0; bj < 2; ++bj)
#pragma unroll
            for (int n = 0; n < 2; ++n) bv[bj][n] = bias ? *(const PG8_GAS f32x4*)(bias + col0 + bj * HALF + 4 * n) : (f32x4){0.f, 0.f, 0.f, 0.f};
#pragma unroll
        for (int ai = 0; ai < 2; ++ai)
#pragma unroll
            for (int m = 0; m < 4; ++m) { bf16_t* rowp = O + (size_t)(row0 + ai * HALF + m * 16) * ldc + col0;
#pragma unroll
                for (int bj = 0; bj < 2; ++bj) { const f32x4 v0 = acc[ai][bj][m][0] * rs[ai][m] + bv[bj][0], v1 = acc[ai][bj][m][1] * rs[ai][m] + bv[bj][1];
                    u32x4 w; w.x = cvt_pk_bf16(v0[0], v0[1]); w.y = cvt_pk_bf16(v0[2], v0[3]); w.z = cvt_pk_bf16(v1[0], v1[1]); w.w = cvt_pk_bf16(v1[2], v1[3]);
                    __builtin_nontemporal_store(w, (PG8_GAS u32x4*)(rowp + bj * HALF)); } }
    }
};
struct EpiSwiglu {
    static constexpr bool PERM = true, AFTER_DRAIN = false;
    bf16_t* O; int ldc; const float* rsc;
    __device__ __forceinline__ void pre(const Unit& u, int wr, int fr, float (&rsp)[8]) const { const int row0 = u.pm * BM + wr * 64 + fr;
#pragma unroll
        for (int i = 0; i < 8; ++i) rsp[i] = rsc ? ((const PG8_GAS float*)rsc)[row0 + (i >> 2) * HALF + (i & 3) * 16] : 1.0f; }
    __device__ __forceinline__ void operator()(const f32x4 (&acc)[2][2][4][2], const Unit& u, int wr, int wc, int fr, int fq, const float (&rsp)[8]) const {
        const int row0 = u.pm * BM + wr * 64 + fr; const int col0 = u.pn * HALF + wc * 32 + 8 * fq;
        float rs[2][4];
#pragma unroll
        for (int ai = 0; ai < 2; ++ai)
#pragma unroll
            for (int m = 0; m < 4; ++m) rs[ai][m] = rsp[ai * 4 + m];
#pragma unroll
        for (int ai = 0; ai < 2; ++ai)
#pragma unroll
            for (int m = 0; m < 4; ++m) { bf16_t* rowp = O + (size_t)(row0 + ai * HALF + m * 16) * ldc + col0;
                float v[8];
#pragma unroll
                for (int n = 0; n < 2; ++n)
#pragma unroll
                    for (int j = 0; j < 4; ++j) { const float g = acc[ai][0][m][n][j] * rs[ai][m], up = acc[ai][1][m][n][j] * rs[ai][m]; v[n * 4 + j] = g * sigm(g) * up; }
                u32x4 w; w.x = cvt_pk_bf16(v[0], v[1]); w.y = cvt_pk_bf16(v[2], v[3]); w.z = cvt_pk_bf16(v[4], v[5]); w.w = cvt_pk_bf16(v[6], v[7]);
                __builtin_nontemporal_store(w, (PG8_GAS u32x4*)rowp); }
    }
};
struct EpiPle {
    static constexpr bool PERM = true, AFTER_DRAIN = false;
    bf16_t* O; const bf16_t* PP; int ldc; const float* rsc;
    __device__ __forceinline__ void pre(const Unit& u, int wr, int fr, float (&rsp)[8]) const { const int row0 = u.pm * BM + wr * 64 + fr;
#pragma unroll
        for (int i = 0; i < 8; ++i) rsp[i] = rsc ? ((const PG8_GAS float*)rsc)[row0 + (i >> 2) * HALF + (i & 3) * 16] : 1.0f; }
    __device__ __forceinline__ void operator()(const f32x4 (&acc)[2][2][4][2], const Unit& u, int wr, int wc, int fr, int fq, const float (&rsp)[8]) const {
        const int row0 = u.pm * BM + wr * 64 + fr, col0 = u.pn * BM + wc * 32 + 8 * fq;
#pragma unroll
        for (int ai = 0; ai < 2; ++ai)
#pragma unroll
            for (int m = 0; m < 4; ++m) { const size_t off = (size_t)(row0 + ai * HALF + m * 16) * ldc + col0; const float rsv = rsp[ai * 4 + m];
#pragma unroll
                for (int bj = 0; bj < 2; ++bj) { const u32x4 pw = *(const PG8_GAS u32x4*)(PP + off + bj * HALF); const f32x4 a0 = acc[ai][bj][m][0] * rsv, a1 = acc[ai][bj][m][1] * rsv;
                    u32x4 w;
                    w.x = cvt_pk_bf16(sigm(a0[0]) * __uint_as_float(pw.x << 16), sigm(a0[1]) * __uint_as_float(pw.x & 0xffff0000u));
                    w.y = cvt_pk_bf16(sigm(a0[2]) * __uint_as_float(pw.y << 16), sigm(a0[3]) * __uint_as_float(pw.y & 0xffff0000u));
                    w.z = cvt_pk_bf16(sigm(a1[0]) * __uint_as_float(pw.z << 16), sigm(a1[1]) * __uint_as_float(pw.z & 0xffff0000u));
                    w.w = cvt_pk_bf16(sigm(a1[2]) * __uint_as_float(pw.w << 16), sigm(a1[3]) * __uint_as_float(pw.w & 0xffff0000u));
                    __builtin_nontemporal_store(w, (PG8_GAS u32x4*)(O + off + bj * HALF)); } }
    }
};
template <class Epi, class Sched, bool ALIGN_EPI = false, bool SP2 = false>
__device__ __forceinline__ void gemm_phase(PG8_LAS unsigned char* lds, const Gemm g, const Sched& S, const Epi& E) {
    int tid_o = threadIdx.x; asm volatile("" : "+v"(tid_o));
    const int tid = tid_o, wid = __builtin_amdgcn_readfirstlane(tid >> 6), lane = tid & 63, wr = wid >> 2, wc = wid & 3, fr = lane & 15, fq = lane >> 4;
    const int K = g.K, nt = K / BK;
    unsigned voffA[2], voffB[2];
#pragma unroll
    for (int i = 0; i < 2; ++i) { int R, C; stage_rc(tid * 16 + i * 8192, R, C); const int Rb = Epi::PERM ? ((R & ~31) + perm32(R & 31)) : R;
        voffA[i] = (unsigned)(R * K + C) * 2u; voffB[i] = (unsigned)(Rb * K + C) * 2u; }
    const size_t kstep = (size_t)(BK * 2);
    const size_t hstep = (size_t)HALF * K * 2;
    const size_t tstep = 2 * hstep;
    const unsigned ldsw = (unsigned)wid * 1024u;
    const int aoff = lds_byte(wr * 64 + fr, fq * 8), boff = lds_byte(wc * 32 + fr, fq * 8);
#define PG8_SA(b, h) (((b) * 2 + (h)) * HTB)
#define PG8_SB(b, h) ((4 + (b) * 2 + (h)) * HTB)
#define PG8_STAGE(bufoff, gbase, voff) do { _Pragma("unroll") for (int _i = 0; _i < 2; ++_i) \
        __builtin_amdgcn_global_load_lds((const unsigned*)((const char*)(gbase) + (voff)[_i]), (PG8_LAS unsigned*)(lds + (bufoff) + ldsw + _i * 8192), 16, 0, 0); } while (0)
#define PG8_LDA(dst, b, h) do { _Pragma("unroll") for (int m = 0; m < 4; ++m) _Pragma("unroll") for (int k = 0; k < 2; ++k) dst[m][k] = *(const PG8_LAS bf16x8*)(lds + PG8_SA(b, h) + aoff + m * 2048 + k * 1024); } while (0)
#define PG8_LDB(dst, b, h) do { _Pragma("unroll") for (int n = 0; n < 2; ++n) _Pragma("unroll") for (int k = 0; k < 2; ++k) dst[n][k] = *(const PG8_LAS bf16x8*)(lds + PG8_SB(b, h) + boff + n * 2048 + k * 1024); } while (0)
#define PG8_MMA(ai, bj, At, Bt) do { __builtin_amdgcn_s_setprio(1); _Pragma("unroll") for (int m = 0; m < 4; ++m) _Pragma("unroll") for (int n = 0; n < 2; ++n) _Pragma("unroll") for (int k = 0; k < 2; ++k) \
        acc[ai][bj][m][n] = __builtin_amdgcn_mfma_f32_16x16x32_bf16(Bt[n][k], At[m][k], acc[ai][bj][m][n], 0, 0, 0); __builtin_amdgcn_s_setprio(0); } while (0)
#define PG8_WAIT_V(n) asm volatile("s_waitcnt vmcnt(" #n ")" ::: "memory")
#define PG8_WAIT_L(n) asm volatile("s_waitcnt lgkmcnt(" #n ")" ::: "memory")
#define PG8_BAR __builtin_amdgcn_s_barrier()
#define PG8_SCHED __builtin_amdgcn_sched_barrier(0)
    Unit cur, nxt; int ui = 0;
    if (!S.next(0, cur)) return;
    f32x4 acc[2][2][4][2];
#pragma unroll
    for (int a = 0; a < 2; ++a)
#pragma unroll
        for (int b = 0; b < 2; ++b)
#pragma unroll
            for (int m = 0; m < 4; ++m)
#pragma unroll
                for (int n = 0; n < 2; ++n) acc[a][b][m][n] = (f32x4){0.f, 0.f, 0.f, 0.f};
    bf16x8 At[4][2], B0[2][2], B1[2][2];
    const char* cA = (const char*)g.A + (size_t)cur.pm * tstep; const char* cB = (const char*)g.Bt + (size_t)cur.pn * tstep;
    S.a_ready(cur);
    if constexpr (SP2) {
        PG8_STAGE(PG8_SB(0, 0), cB, voffB); PG8_STAGE(PG8_SB(0, 1), cB + hstep, voffB); PG8_STAGE(PG8_SA(0, 0), cA, voffA); PG8_STAGE(PG8_SA(0, 1), cA + hstep, voffA);
        if (wr == 1) PG8_BAR;
        PG8_WAIT_V(2); PG8_BAR;
        PG8_STAGE(PG8_SB(1, 0), cB + kstep, voffB); PG8_STAGE(PG8_SA(1, 0), cA + kstep, voffA); PG8_STAGE(PG8_SB(1, 1), cB + hstep + kstep, voffB);
        PG8_WAIT_V(6); PG8_BAR;
    } else {
        PG8_STAGE(PG8_SB(0, 0), cB, voffB); PG8_STAGE(PG8_SA(0, 0), cA, voffA); PG8_STAGE(PG8_SB(0, 1), cB + hstep, voffB); PG8_STAGE(PG8_SA(0, 1), cA + hstep, voffA);
        if (wr == 1) PG8_BAR;
        PG8_WAIT_V(4); PG8_BAR;
        PG8_STAGE(PG8_SB(1, 0), cB + kstep, voffB); PG8_STAGE(PG8_SA(1, 0), cA + kstep, voffA); PG8_STAGE(PG8_SB(1, 1), cB + hstep + kstep, voffB);
        PG8_WAIT_V(6); PG8_BAR;
    }
    for (;;) {
        const bool has_next = S.next(ui + 1, nxt);
        float rsp[8]; E.pre(cur, wr, fr, rsp);
        const char* nA = has_next ? (const char*)g.A + (size_t)nxt.pm * tstep : cA; const char* nB = has_next ? (const char*)g.Bt + (size_t)nxt.pn * tstep : cB;
        for (int t = 0; t < nt; t += 2) {
            const bool last = (t == nt - 2);
            const char* a1 = cA + (size_t)(t + 1) * kstep;
            const char* a2 = last ? nA : cA + (size_t)(t + 2) * kstep; const char* b2 = last ? nB : cB + (size_t)(t + 2) * kstep;
            const char* a3 = a2 + kstep; const char* b3 = b2 + kstep;
            if (last && has_next) S.a_ready(nxt);
            if constexpr (SP2) {
            PG8_LDB(B0, 0, 0); PG8_LDB(B1, 0, 1); PG8_SCHED; PG8_LDA(At, 0, 0); PG8_STAGE(PG8_SA(1, 1), a1 + hstep, voffA);
            PG8_WAIT_V(8); PG8_WAIT_L(0); PG8_BAR; PG8_MMA(0, 0, At, B0); PG8_MMA(0, 1, At, B1); PG8_BAR; PG8_SCHED;
            PG8_LDA(At, 0, 1); PG8_STAGE(PG8_SB(0, 0), b2, voffB); PG8_STAGE(PG8_SB(0, 1), b2 + hstep, voffB); PG8_STAGE(PG8_SA(0, 0), a2, voffA);
            PG8_WAIT_V(8); PG8_WAIT_L(0); PG8_BAR; PG8_MMA(1, 0, At, B0); PG8_MMA(1, 1, At, B1); PG8_BAR; PG8_SCHED;
            PG8_LDB(B0, 1, 0); PG8_LDB(B1, 1, 1); PG8_SCHED; PG8_LDA(At, 1, 0); PG8_STAGE(PG8_SA(0, 1), a2 + hstep, voffA);
            PG8_WAIT_V(8); PG8_WAIT_L(0); PG8_BAR; PG8_MMA(0, 0, At, B0); PG8_MMA(0, 1, At, B1); PG8_BAR; PG8_SCHED;
            PG8_LDA(At, 1, 1); PG8_STAGE(PG8_SB(1, 0), b3, voffB); PG8_STAGE(PG8_SB(1, 1), b3 + hstep, voffB); PG8_STAGE(PG8_SA(1, 0), a3, voffA);
            PG8_WAIT_V(8); PG8_WAIT_L(0); PG8_BAR; PG8_MMA(1, 0, At, B0); PG8_MMA(1, 1, At, B1); PG8_BAR; PG8_SCHED;
            } else {
            PG8_LDB(B0, 0, 0); PG8_SCHED; PG8_LDA(At, 0, 0); PG8_STAGE(PG8_SA(1, 1), a1 + hstep, voffA);
            PG8_WAIT_L(8); PG8_BAR; PG8_WAIT_L(0); PG8_MMA(0, 0, At, B0); PG8_BAR; PG8_SCHED;
            PG8_LDB(B1, 0, 1); PG8_STAGE(PG8_SB(0, 0), b2, voffB);
            PG8_BAR; PG8_WAIT_L(0); PG8_MMA(0, 1, At, B1); PG8_BAR;
            PG8_LDA(At, 0, 1); PG8_STAGE(PG8_SA(0, 0), a2, voffA);
            PG8_BAR; PG8_WAIT_L(0); PG8_MMA(1, 0, At, B0); PG8_BAR; PG8_SCHED;
            PG8_STAGE(PG8_SB(0, 1), b2 + hstep, voffB);
            PG8_WAIT_V(6); PG8_BAR; PG8_MMA(1, 1, At, B1); PG8_BAR;
            PG8_LDB(B0, 1, 0); PG8_SCHED; PG8_LDA(At, 1, 0); PG8_STAGE(PG8_SA(0, 1), a2 + hstep, voffA);
            PG8_WAIT_L(8); PG8_BAR; PG8_WAIT_L(0); PG8_MMA(0, 0, At, B0); PG8_BAR; PG8_SCHED;
            PG8_LDB(B1, 1, 1); PG8_STAGE(PG8_SB(1, 0), b3, voffB);
            PG8_BAR; PG8_WAIT_L(0); PG8_MMA(0, 1, At, B1); PG8_BAR;
            PG8_LDA(At, 1, 1); PG8_STAGE(PG8_SA(1, 0), a3, voffA);
            PG8_BAR; PG8_WAIT_L(0); PG8_MMA(1, 0, At, B0); PG8_BAR; PG8_SCHED;
            PG8_STAGE(PG8_SB(1, 1), b3 + hstep, voffB);
            PG8_WAIT_V(6); PG8_BAR; PG8_MMA(1, 1, At, B1); PG8_BAR;
            }
        }
        if constexpr (ALIGN_EPI) { if (wr == 0) PG8_BAR; }
        if constexpr (!Epi::AFTER_DRAIN) { E(acc, cur, wr, wc, fr, fq, rsp); S.done(cur); }
        if (!has_next) break;
#pragma unroll
        for (int a = 0; a < 2; ++a)
#pragma unroll
            for (int b = 0; b < 2; ++b)
#pragma unroll
                for (int m = 0; m < 4; ++m)
#pragma unroll
                    for (int n = 0; n < 2; ++n) acc[a][b][m][n] = (f32x4){0.f, 0.f, 0.f, 0.f};
        cur = nxt; cA = nA; cB = nB; ++ui;
        if constexpr (ALIGN_EPI) { if (wr == 1) PG8_BAR; }
    }
    PG8_WAIT_V(0);
    if constexpr (!ALIGN_EPI) { if (wr == 0) PG8_BAR; }
    PG8_BAR;
    if constexpr (Epi::AFTER_DRAIN) { E.fused(acc, cur, wr, wc, fr, fq, lds, wid, lane); S.done(cur); }
#undef PG8_SA
#undef PG8_SB
#undef PG8_STAGE
#undef PG8_LDA
#undef PG8_LDB
#undef PG8_MMA
#undef PG8_WAIT_V
#undef PG8_WAIT_L
#undef PG8_BAR
#undef PG8_SCHED
}
}

#ifndef MK_SPLIT
#define MK_SPLIT 0
#endif
#define DEVI __device__ __forceinline__
#define LAS __attribute__((address_space(3)))
#define GAS __attribute__((address_space(1)))
typedef unsigned short bf16;
typedef float f32x4 __attribute__((ext_vector_type(4)));
typedef float f32x16 __attribute__((ext_vector_type(16)));
typedef short bf16x8 __attribute__((ext_vector_type(8)));
typedef short s16x4 __attribute__((ext_vector_type(4)));
typedef short v4i16_t __attribute__((ext_vector_type(4)));
typedef unsigned u32x4 __attribute__((ext_vector_type(4)));
typedef unsigned u32x2 __attribute__((ext_vector_type(2)));
typedef GAS unsigned gu32;

constexpr int NWAVES = 8, NTHR = 512;
constexpr int BATCH = 2, SEQ = 8192, M = BATCH * SEQ, DM = 4096, DFF = 11008, DEPTH = 2;
constexpr int NIN = 10824, NINP = 11008;
constexpr int C_RQ = 0, C_RK = 1024, C_RV = 2048, C_RG = 3072, C_CQ = 4096, C_CKV = 5120, C_KR = 5632, C_FQ = 5696, C_FK = 6720, C_FV = 7744, C_FF = 8768, C_CIN = 8776;
constexpr float NORM_EPS = 1e-6f, LN_EPS = 1e-5f;
constexpr float LOG2E = 1.4426950408889634f;

constexpr size_t MiB = 1u << 20;
constexpr size_t WS_CTL = 0, CTL_ZERO_BYTES = 1 * MiB;
constexpr size_t WS_WGU1 = 1 * MiB, WS_WD1 = 173 * MiB, WS_WGU2 = 259 * MiB, WS_WD2 = 431 * MiB, WS_WIN = 517 * MiB, WS_WOUT = 603 * MiB, WS_WPG = 635 * MiB,
                 WS_WPP = 667 * MiB, WS_WUQ = 669 * MiB, WS_WUKV = 672 * MiB, WS_WPW = 674 * MiB;
constexpr size_t WS_HN = 676 * MiB, WS_ACT = 804 * MiB, WS_Y = 1148 * MiB, WS_CAT = 1404 * MiB, WS_PPB = 1532 * MiB, WS_P16 = 1660 * MiB;
constexpr size_t WS_COS128 = 1676 * MiB, WS_SIN128 = 1680 * MiB, WS_COS64 = 1684 * MiB, WS_SIN64 = 1686 * MiB;
constexpr size_t WS_RQ = 1688 * MiB, WS_RK = 1720 * MiB, WS_CQN = 1752 * MiB, WS_CKVN = 1784 * MiB, WS_KR = 1800 * MiB, WS_LOGF = 1802 * MiB, WS_CUM2 = 1803 * MiB,
                 WS_U = 1804 * MiB, WS_YC = 1836 * MiB, WS_MQ = 1868 * MiB, WS_KVR = 1916 * MiB, WS_KVC = 1980 * MiB, WS_ST = 2044 * MiB, WS_H16 = 2076 * MiB, WS_RS = 2204 * MiB, WS_END = 2205 * MiB;
constexpr int CW_BAR = 4096;
constexpr int CW_QK = 16384;

constexpr int RING_BYTES = 131072, LDSCTL_OFF = RING_BYTES, LDS_BYTES = 147456;

#define LDS_WAIT() asm volatile("s_waitcnt lgkmcnt(0)" ::: "memory")
DEVI float bf2f(unsigned b) { return __uint_as_float(b << 16); }
DEVI unsigned f2bf(float f) { unsigned u = __float_as_uint(f); return (u + 0x7fffu + ((u >> 16) & 1u)) >> 16; }
DEVI unsigned pk2(float lo, float hi) { return pg8::cvt_pk_bf16(lo, hi); }
DEVI void unpack8(const u32x4 w, float (&f)[8]) {
    f[0] = __uint_as_float(w.x << 16); f[1] = __uint_as_float(w.x & 0xffff0000u); f[2] = __uint_as_float(w.y << 16); f[3] = __uint_as_float(w.y & 0xffff0000u);
    f[4] = __uint_as_float(w.z << 16); f[5] = __uint_as_float(w.z & 0xffff0000u); f[6] = __uint_as_float(w.w << 16); f[7] = __uint_as_float(w.w & 0xffff0000u); }
DEVI u32x4 pack8(const float (&f)[8]) { u32x4 w; w.x = pk2(f[0], f[1]); w.y = pk2(f[2], f[3]); w.z = pk2(f[4], f[5]); w.w = pk2(f[6], f[7]); return w; }
DEVI float wave_sum(float v) {
#pragma unroll
    for (int o = 1; o < 64; o <<= 1) v += __shfl_xor(v, o);
    return v; }
DEVI float sigm(float x) { return __builtin_amdgcn_rcpf(1.0f + __builtin_amdgcn_exp2f(-LOG2E * x)); }
template <int MASK> DEVI float shxor(float v) { static_assert(MASK > 0 && MASK < 32, "ds_swizzle bit mode"); return __builtin_bit_cast(float, __builtin_amdgcn_ds_swizzle(__builtin_bit_cast(int, v), (MASK << 10) | 0x1f)); }
DEVI float max32(float v) { unsigned a = __builtin_bit_cast(unsigned, v), b = a; asm volatile("s_nop 1\n\tv_permlane32_swap_b32 %0, %1" : "+v"(a), "+v"(b)); return fmaxf(__builtin_bit_cast(float, a), __builtin_bit_cast(float, b)); }
DEVI float wave_max(float v) { v = fmaxf(v, shxor<1>(v)); v = fmaxf(v, shxor<2>(v)); v = fmaxf(v, shxor<4>(v)); v = fmaxf(v, shxor<8>(v)); v = fmaxf(v, shxor<16>(v)); return max32(v); }
DEVI int crow(int r, int hi) { return (r & 3) + 8 * (r >> 2) + 4 * hi; }
DEVI s16x4 vtr(const LAS unsigned char* p) { return __builtin_bit_cast(s16x4, __builtin_amdgcn_ds_read_tr16_b64_v4i16((LAS v4i16_t*)p)); }
DEVI bf16x8 cat44(s16x4 a, s16x4 b) { return (bf16x8){a[0], a[1], a[2], a[3], b[0], b[1], b[2], b[3]}; }
DEVI bf16x8 packp8(const f32x16& p, int s) { u32x4 w; w.x = pg8::cvt_pk_bf16(p[8 * s + 0], p[8 * s + 1]); w.y = pg8::cvt_pk_bf16(p[8 * s + 2], p[8 * s + 3]);
    w.z = pg8::cvt_pk_bf16(p[8 * s + 4], p[8 * s + 5]); w.w = pg8::cvt_pk_bf16(p[8 * s + 6], p[8 * s + 7]); return __builtin_bit_cast(bf16x8, w); }
#define MFMA32(a, b, c) __builtin_amdgcn_mfma_f32_32x32x16_bf16((a), (b), (c), 0, 0, 0)

DEVI unsigned long long rfl64(unsigned long long v) { const unsigned lo = __builtin_amdgcn_readfirstlane((unsigned)v), hi = __builtin_amdgcn_readfirstlane((unsigned)(v >> 32)); return ((unsigned long long)hi << 32) | lo; }
#define XB_TMO      128
#define XB_XCNT(j)  (256  + 64 * (j))
#define XB_XSUB(j)  (1280 + 64 * (j))
#define XB_XGEN(j)  (2304 + 64 * (j))
#define XB_TOP      3328
#define XB_TOPGEN   3392
#define XCD_BAR_WORDS 3456
#define XB_SPIN_CAP (1u << 18)

__device__ __forceinline__ unsigned xb_ld(unsigned* p)              { return __hip_atomic_load(p, __ATOMIC_RELAXED, __HIP_MEMORY_SCOPE_AGENT); }
__device__ __forceinline__ unsigned xb_add(unsigned* p, unsigned v) { return __hip_atomic_fetch_add(p, v, __ATOMIC_RELAXED, __HIP_MEMORY_SCOPE_AGENT); }
__device__ __forceinline__ unsigned xb_xcc_id() { return (unsigned)__builtin_amdgcn_s_getreg((3 << 11) | 20) & 0xFu; }
#define XB_SPIN(cond, bar) do { unsigned _sp = 0; while (cond) { __builtin_amdgcn_s_sleep(1); \
    if ((++_sp & 255u) == 0u) { if (xb_ld(&(bar)[XB_TMO])) break; if (_sp > XB_SPIN_CAP) { atomicAdd(&(bar)[XB_TMO], 1u); break; } } } } while (0)

struct XcdBarrier {
    unsigned* bar; unsigned x;
    volatile LAS unsigned* st;
};

__device__ __forceinline__ XcdBarrier xcd_barrier_post(unsigned* bar, volatile LAS unsigned* st) {
    XcdBarrier b; b.bar = bar; b.x = xb_xcc_id(); b.st = st;
    if (threadIdx.x == 0) (void)xb_add(&bar[XB_XCNT(b.x)], 1u);
    return b;
}
__device__ __forceinline__ void xcd_barrier_complete(unsigned* bar, unsigned x, unsigned& nloc, unsigned& nx) {
    const unsigned G = gridDim.x * gridDim.y * gridDim.z;
    unsigned sum, cnt, mine, sp = 0u;
    for (;;) {
        sum = 0u; cnt = 0u; mine = 0u;
#pragma unroll
        for (unsigned j = 0; j < 16; ++j) { const unsigned c = xb_ld(&bar[XB_XCNT(j)]); sum += c; cnt += (c > 0u) ? 1u : 0u; mine = (j == x) ? c : mine; }
        if (sum == G) break;
        __builtin_amdgcn_s_sleep(1);
        if ((++sp & 255u) == 0u) { if (xb_ld(&bar[XB_TMO])) break; if (sp > XB_SPIN_CAP) { atomicAdd(&bar[XB_TMO], 1u); break; } }
    }
    nloc = mine > 0u ? mine : 1u; nx = cnt > 0u ? cnt : 1u;
}

__device__ __forceinline__ void xcd_barrier(const XcdBarrier& b) {
    asm volatile("s_waitcnt vmcnt(0)" ::: "memory");
    __syncthreads();
    if (threadIdx.x == 0) {
        unsigned* bar = b.bar;
        __builtin_amdgcn_s_waitcnt(0);
        unsigned nloc = b.st[0], nx = b.st[1];
        if (nloc == 0u) { xcd_barrier_complete(bar, b.x, nloc, nx); b.st[0] = nloc; b.st[1] = nx; }
        const unsigned old = xb_add(&bar[XB_XSUB(b.x)], 1u);
        const unsigned gen = old / nloc;
        if (old + 1u == (gen + 1u) * nloc) {
            __builtin_amdgcn_fence(__ATOMIC_RELEASE, "agent");
            asm volatile("s_waitcnt vmcnt(0)" ::: "memory");
            const unsigned og = xb_add(&bar[XB_TOP], 1u);
            const unsigned tg = og / nx;
            if (og + 1u == (tg + 1u) * nx) xb_add(&bar[XB_TOPGEN], 1u);
            else XB_SPIN(xb_ld(&bar[XB_TOPGEN]) == tg, bar);
            __builtin_amdgcn_fence(__ATOMIC_ACQUIRE, "agent");
            xb_add(&bar[XB_XGEN(b.x)], 1u);
            asm volatile("s_waitcnt vmcnt(0)" ::: "memory");
        } else {
            XB_SPIN(xb_ld(&bar[XB_XGEN(b.x)]) == gen, bar);
            __builtin_amdgcn_fence(__ATOMIC_ACQUIRE, "agent");
            asm volatile("s_waitcnt vmcnt(0)" ::: "memory");
        }
    }
    __syncthreads();
}

DEVI void tr_item(const float* __restrict__ W, int K, int N, bf16* __restrict__ WT, int dst_row0, LAS float* scr, int k0, int n0, int lane, const float* __restrict__ gk = nullptr) {
    const int c = lane & 31; const bool ok = (n0 + c) < N;
#pragma unroll
    for (int i = 0; i < 32; ++i) { const int kk = 2 * i + (lane >> 5); scr[kk * 33 + c] = ok ? W[(size_t)(k0 + kk) * N + n0 + c] : 0.f; }
    LDS_WAIT(); asm volatile("" ::: "memory");
    const int ch = lane & 7;
    f32x4 g0 = {1.f, 1.f, 1.f, 1.f}, g1 = g0; if (gk) { g0 = *(const f32x4*)(gk + k0 + 8 * ch); g1 = *(const f32x4*)(gk + k0 + 8 * ch + 4); }
#pragma unroll
    for (int j = 0; j < 4; ++j) { const int n = (lane >> 3) + 8 * j; const LAS float* s = scr + (8 * ch) * 33 + n;
        u32x4 o; o.x = pk2(s[0 * 33] * g0[0], s[1 * 33] * g0[1]); o.y = pk2(s[2 * 33] * g0[2], s[3 * 33] * g0[3]); o.z = pk2(s[4 * 33] * g1[0], s[5 * 33] * g1[1]); o.w = pk2(s[6 * 33] * g1[2], s[7 * 33] * g1[3]);
        *(u32x4*)(WT + (size_t)(dst_row0 + n) * K + k0 + 8 * ch) = o; }
    LDS_WAIT(); asm volatile("" ::: "memory");
}

template <bool FIRST, bool LAST, bool HAS_HN, bool GREG = false>
DEVI void norm_row(const void* __restrict__ hin, void* __restrict__ hout, const bf16* __restrict__ y, float coef, const float* __restrict__ gpost, float* __restrict__ hn  , int lane, const f32x4* greg = nullptr) {
    f32x4 v[16];
    if (!GREG) asm volatile("" : "+s"(gpost));
    if (FIRST) {
#pragma unroll
        for (int j = 0; j < 16; ++j) v[j] = ((const f32x4*)hin)[lane + 64 * j];
    } else {
        u32x2 yw[16], hw[16]; float ss = 0.f;
#pragma unroll
        for (int j = 0; j < 16; ++j) yw[j] = ((const u32x2*)y)[lane + 64 * j];
#pragma unroll
        for (int j = 0; j < 16; ++j) hw[j] = ((const u32x2*)hin)[lane + 64 * j];
#pragma unroll
        for (int j = 0; j < 16; ++j) { const float a = __uint_as_float(yw[j].x << 16), b = __uint_as_float(yw[j].x & 0xffff0000u), c = __uint_as_float(yw[j].y << 16), d = __uint_as_float(yw[j].y & 0xffff0000u); ss += (a * a + b * b) + (c * c + d * d); }
        const float rs = coef / sqrtf(wave_sum(ss) * (1.0f / DM) + NORM_EPS);
#pragma unroll
        for (int j = 0; j < 16; ++j) { const f32x4 g = GREG ? greg[j] : ((const f32x4*)gpost)[lane + 64 * j];
            const f32x4 yv = (f32x4){__uint_as_float(yw[j].x << 16), __uint_as_float(yw[j].x & 0xffff0000u), __uint_as_float(yw[j].y << 16), __uint_as_float(yw[j].y & 0xffff0000u)};
            const f32x4 hv = (f32x4){__uint_as_float(hw[j].x << 16), __uint_as_float(hw[j].x & 0xffff0000u), __uint_as_float(hw[j].y << 16), __uint_as_float(hw[j].y & 0xffff0000u)};
            v[j] = hv + yv * rs * g;
            if ((j & 3) == 3) { asm volatile("" : "+v"(v[j - 3]), "+v"(v[j - 2]), "+v"(v[j - 1]), "+v"(v[j]) :: "memory"); } }
    }
    if (LAST) {
#pragma unroll
        for (int j = 0; j < 16; ++j) ((f32x4*)hout)[lane + 64 * j] = v[j];
    } else {
#pragma unroll
        for (int j = 0; j < 16; ++j) { u32x2 o; o.x = pk2(v[j].x, v[j].y); o.y = pk2(v[j].z, v[j].w); ((u32x2*)hout)[lane + 64 * j] = o; }
    }
    if (HAS_HN) {
        float ss = 0.f;
#pragma unroll
        for (int j = 0; j < 16; ++j) ss += (v[j].x * v[j].x + v[j].y * v[j].y) + (v[j].z * v[j].z + v[j].w * v[j].w);
        const float rs = 1.0f / sqrtf(wave_sum(ss) * (1.0f / DM) + NORM_EPS);
        if (lane == 0) *(float*)hn = rs;
    }
    asm volatile("" ::: "memory");
}

DEVI void sincos_d(float ang, float& s_out, float& c_out) {
    const double a = (double)ang; const double q = __builtin_rint(a * 0.63661977236758134308);
    double y = __builtin_fma(-q, 1.57079632679489655800, a); y = __builtin_fma(-q, 6.123233995736766036e-17, y);
    const double y2 = y * y;
    double sp = 1.0 / 6227020800.0; sp = sp * y2 - 1.0 / 39916800.0; sp = sp * y2 + 1.0 / 362880.0; sp = sp * y2 - 1.0 / 5040.0; sp = sp * y2 + 1.0 / 120.0; sp = sp * y2 - 1.0 / 6.0; sp = sp * y2 + 1.0; sp = sp * y;
    double cp = -1.0 / 87178291200.0; cp = cp * y2 + 1.0 / 479001600.0; cp = cp * y2 - 1.0 / 3628800.0; cp = cp * y2 + 1.0 / 40320.0; cp = cp * y2 - 1.0 / 720.0; cp = cp * y2 + 1.0 / 24.0; cp = cp * y2 - 0.5; cp = cp * y2 + 1.0;
    const int qi = ((int)q) & 3;
    const double s = (qi == 0) ? sp : (qi == 1) ? cp : (qi == 2) ? -sp : -cp;
    const double c = (qi == 0) ? cp : (qi == 1) ? -sp : (qi == 2) ? -cp : sp;
    s_out = (float)s; c_out = (float)c;
}
DEVI float inv_freq(int i, double base) { double r = 1.0, b = base;
#pragma unroll
    for (int bit = 0; bit < 6; ++bit) { if ((i >> bit) & 1) r *= b; b *= b; }
    return (float)r; }
DEVI float ret_lg2(int h) {
    const double x = 1.0 / (double)(1 << (5 + h)); double t = x, s = 0.0;
#pragma unroll
    for (int k = 1; k <= 12; ++k) { s += t / (double)k; t *= x; }
    return (float)(-s * 1.4426950408889634074);
}

template <int DK, bool FOX>
DEVI void attn_unit(LAS unsigned char* lds, int b, int qb, const bf16* __restrict__ Qp, int qpitch, const bf16* __restrict__ K1p, int k1pitch, const bf16* __restrict__ K2p, int k2pitch,
                    const bf16* __restrict__ Vp, int vpitch, const float* __restrict__ cum2, bf16* __restrict__ Op, int opitch, float c2, float qkmax2) {
    constexpr int KSTR = (DK == 128) ? 272 : 400, VSTR = 320, NCH = DK / 8, NDS = DK / 16, NPARK = 0, NPRING = 0;
    int tid_o = threadIdx.x; asm volatile("" : "+v"(tid_o));
    const int tid = tid_o, w = __builtin_amdgcn_readfirstlane(tid >> 6), lane = tid & 63, r32 = lane & 31, hi = lane >> 5;
    const int t = qb * 256 + w * 32 + r32;
    const size_t mq = (size_t)b * SEQ + t;
    constexpr int NQR = NDS - NPARK;
    bf16x8 qf[NQR];
#pragma unroll
    for (int ds = 0; ds < NQR; ++ds) qf[ds] = *(const bf16x8*)(Qp + mq * qpitch + 16 * ds + 8 * hi);
    static_assert(3 * (64 * KSTR + 256) + 2 * (64 * VSTR) + 8 * NPRING * 1024 <= RING_BYTES && 2048 + 8 * (NPARK - NPRING) * 1024 <= LDS_BYTES - LDSCTL_OFF, "attention LDS budget");
    LAS unsigned char* qpark = lds + 3 * (64 * KSTR + 256) + 2 * (64 * VSTR) + w * (NPRING * 1024) + lane * 16;
    LAS unsigned char* qpark2 = lds + LDSCTL_OFF + 2048 + w * ((NPARK - NPRING) * 1024) + lane * 16;
    {
#pragma unroll
        for (int ds = NQR; ds < NDS; ++ds) *(LAS bf16x8*)((ds - NQR < NPRING) ? qpark + (ds - NQR) * 1024 : qpark2 + (ds - NQR - NPRING) * 1024) = *(const bf16x8*)(Qp + mq * qpitch + 16 * ds + 8 * hi); }
    float ct2 = 0.f; if (FOX) ct2 = cum2[t];
    f32x16 o[4];
#pragma unroll
    for (int d0 = 0; d0 < 4; ++d0)
#pragma unroll
        for (int r = 0; r < 16; ++r) o[d0][r] = 0.f;
    float m_run = -1e30f, l_run = 0.f;
    const int NT = 4 * (qb + 1), jlast = 4 * qb + (w >> 1);
    const int qfirst = qb * 256 + w * 32;
    int j0 = 0;
    if (FOX) { const float thr = -(2.0f * qkmax2 + 64.0f), cT0 = cum2[qb * 256];
        const int ja = lane, jb = lane + 64;
        const bool da = (ja < NT) && (cT0 - cum2[64 * ja + 63] < thr), db = (jb < NT) && (cT0 - cum2[64 * jb + 63] < thr);
        j0 = __builtin_popcountll(__ballot(da)) + __builtin_popcountll(__ballot(db)); j0 = __builtin_amdgcn_readfirstlane(j0); if (j0 > 4 * qb) j0 = 4 * qb; }
    const size_t mk0 = (size_t)b * SEQ;
    constexpr int KB = 64 * KSTR + 256, VB = 64 * VSTR;
    constexpr int KSPR = KSTR / 16, VSPR = VSTR / 16, NIK = 64 * KSPR / 64, NIV = 64 * VSPR / 64, NKD = (NIK + 7) / 8, NVD = (NIV + 7) / 8;
    constexpr int NKOPS = NKD + (FOX ? 1 : 0), NVOPS = NVD;
    unsigned koff[NKD], voff[NVD]; unsigned k2mask = 0u;
#pragma unroll
    for (int i = 0; i < NKD; ++i) { int n = w + 8 * i; if (n >= NIK) n -= 8; const int s_ = 64 * n + lane, row = s_ / KSPR; int ch = s_ % KSPR; if (ch >= NCH) ch = 0;
        if (ch < 16) koff[i] = (unsigned)(row * k1pitch + ch * 8) * 2u; else { koff[i] = (unsigned)(row * k2pitch + (ch - 16) * 8) * 2u; k2mask |= 1u << i; } }
#pragma unroll
    for (int i = 0; i < NVD; ++i) { int n = w + 8 * i; if (n >= NIV) n -= 8; const int s_ = 64 * n + lane, row = s_ / VSPR; int ch = s_ % VSPR; if (ch >= 16) ch = 0; voff[i] = (unsigned)(row * vpitch + ch * 8) * 2u; }
#define ATT_DMAK(tt) do { const int t_ = (tt) < NTt ? (tt) : NTt - 1; const int j_ = j0 + t_; LAS unsigned char* Kw = lds + ((tt) % 3) * KB; \
        const GAS char* kb1 = (const GAS char*)(K1p + (mk0 + 64 * j_) * k1pitch); const GAS char* kb2 = (const GAS char*)(K2p + (mk0 + 64 * j_) * k2pitch); \
        _Pragma("unroll") for (int i = 0; i < NKD; ++i) { int n = w + 8 * i; if (n >= NIK) n -= 8; const GAS char* sp_ = ((k2mask >> i) & 1u) ? kb2 + koff[i] : kb1 + koff[i]; \
            __builtin_amdgcn_global_load_lds((const GAS unsigned*)sp_, (LAS unsigned*)(Kw + n * 1024), 16, 0, 0); } \
        if (FOX) __builtin_amdgcn_global_load_lds((const GAS unsigned*)((const GAS float*)cum2 + 64 * j_ + lane), (LAS unsigned*)(Kw + 64 * KSTR), 4, 0, 0); } while (0)
#define ATT_DMAV(tt) do { const int t_ = (tt) < NTt ? (tt) : NTt - 1; LAS unsigned char* Vw = lds + 3 * KB + ((tt) & 1) * VB; const GAS char* vb_ = (const GAS char*)(Vp + (mk0 + 64 * (j0 + t_)) * vpitch); \
        _Pragma("unroll") for (int i = 0; i < NVD; ++i) { int n = w + 8 * i; if (n >= NIV) n -= 8; __builtin_amdgcn_global_load_lds((const GAS unsigned*)(vb_ + voff[i]), (LAS unsigned*)(Vw + n * 1024), 16, 0, 0); } } while (0)
#define ATT_WAITBAR(N) asm volatile("s_waitcnt vmcnt(%0) lgkmcnt(0)\n\ts_barrier" :: "n"(N) : "memory")
    const int NTt = NT - j0;
    f32x16 p0, p1;
#pragma unroll
    for (int r = 0; r < 16; ++r) { p0[r] = 0.f; p1[r] = 0.f; }
    asm volatile("s_waitcnt vmcnt(0) lgkmcnt(0)" ::: "memory"); __syncthreads();
    ATT_DMAK(0); ATT_DMAK(1); ATT_DMAV(0);
    ATT_WAITBAR(0);
    for (int tl = 0; tl < NTt; ++tl) { const int j = j0 + tl;
        ATT_DMAV(tl + 1); ATT_DMAK(tl + 2);
        if (j <= jlast) {
            const LAS unsigned char* Kt = lds + (tl % 3) * KB; const LAS float* cs = (const LAS float*)(Kt + 64 * KSTR);
            int ln1 = lane; asm volatile("" : "+v"(ln1));
            const LAS unsigned char* ka = Kt + (ln1 & 31) * KSTR + (ln1 >> 5) * 16;
            bf16x8 fa[2][4];
#define ATT_LOADP(bf_, pr_) do { fa[bf_][0] = *(const LAS bf16x8*)(ka + (2 * (pr_)) * 32); fa[bf_][1] = *(const LAS bf16x8*)(ka + 32 * KSTR + (2 * (pr_)) * 32); \
                                 fa[bf_][2] = *(const LAS bf16x8*)(ka + (2 * (pr_) + 1) * 32); fa[bf_][3] = *(const LAS bf16x8*)(ka + 32 * KSTR + (2 * (pr_) + 1) * 32); } while (0)
#define ATT_QV(ds_) (((ds_) < NQR) ? qf[(ds_) < NQR ? (ds_) : 0] : *(const LAS bf16x8*)(((ds_) - NQR < NPRING) ? qpark + ((ds_) - NQR) * 1024 : qpark2 + ((ds_) - NQR - NPRING) * 1024))
            ATT_LOADP(0, 0); ATT_LOADP(1, 1); __builtin_amdgcn_sched_barrier(0);
#pragma unroll
            for (int r = 0; r < 16; ++r) { p0[r] = 0.f; p1[r] = 0.f; }
#pragma unroll
            for (int pr = 0; pr < NDS / 2; ++pr) { const bf16x8 q0 = ATT_QV(2 * pr), q1 = ATT_QV(2 * pr + 1);
                p0 = MFMA32(fa[pr & 1][0], q0, p0); p1 = MFMA32(fa[pr & 1][1], q0, p1); p0 = MFMA32(fa[pr & 1][2], q1, p0); p1 = MFMA32(fa[pr & 1][3], q1, p1);
                __builtin_amdgcn_sched_barrier(0);
                if (pr + 2 < NDS / 2) { ATT_LOADP(pr & 1, pr + 2); __builtin_amdgcn_sched_barrier(0); } }
#undef ATT_LOADP
#undef ATT_QV
            if (FOX) {
#pragma unroll
                for (int g4 = 0; g4 < 4; ++g4) { const f32x4 c0 = *(const LAS f32x4*)(cs + 8 * g4 + 4 * hi), c1 = *(const LAS f32x4*)(cs + 32 + 8 * g4 + 4 * hi);
#pragma unroll
                    for (int e = 0; e < 4; ++e) { p0[4 * g4 + e] = __builtin_fmaf(p0[4 * g4 + e], c2, ct2 - c0[e]); p1[4 * g4 + e] = __builtin_fmaf(p1[4 * g4 + e], c2, ct2 - c1[e]); } }
            }
            {
            int ln2 = lane; asm volatile("" : "+v"(ln2));
            const LAS unsigned char* vbase = lds + 3 * KB + (tl & 1) * VB + (4 * (ln2 >> 5) + ((ln2 >> 2) & 3)) * VSTR + (16 * ((ln2 >> 4) & 1) + 4 * (ln2 & 3)) * 2;
            s16x4 fv[2][8];
#define ATT_LOADV(bf_, d0_) do { _Pragma("unroll") for (int s = 0; s < 4; ++s) { fv[bf_][2 * s] = vtr(vbase + (16 * s) * VSTR + (d0_) * 64); fv[bf_][2 * s + 1] = vtr(vbase + (16 * s + 8) * VSTR + (d0_) * 64); } } while (0)
            ATT_LOADV(0, 0); __builtin_amdgcn_sched_barrier(0);
            if (64 * j + 63 > qfirst) {
                const float NEG = -__builtin_inff();
                const int tq = qfirst + (ln2 & 31);
#pragma unroll
                for (int r = 0; r < 16; ++r) { const int key = 64 * j + crow(r, ln2 >> 5); if (key > tq) p0[r] = NEG; if (key + 32 > tq) p1[r] = NEG; }
            }
            float zmax = p0[0];
#pragma unroll
            for (int r = 1; r < 16; ++r) zmax = fmaxf(zmax, p0[r]);
#pragma unroll
            for (int r = 0; r < 16; ++r) zmax = fmaxf(zmax, p1[r]);
            zmax = fmaxf(zmax, __shfl_xor(zmax, 32));
            const float sc = FOX ? 1.0f : c2, zs = zmax * sc;
            const bool need = zs > m_run + 8.0f;
            const float alpha = need ? __builtin_amdgcn_exp2f(m_run - zs) : 1.0f; if (need) m_run = zs;
            const float nm = -m_run;
            float ps = 0.f;
#pragma unroll
            for (int r = 0; r < 16; ++r) { p0[r] = __builtin_amdgcn_exp2f(__builtin_fmaf(p0[r], sc, nm)); p1[r] = __builtin_amdgcn_exp2f(__builtin_fmaf(p1[r], sc, nm)); ps += p0[r] + p1[r]; }
            ps += __shfl_xor(ps, 32);
            l_run = l_run * alpha + ps;
            if (__any(need)) {
#pragma unroll
                for (int d0 = 0; d0 < 4; ++d0)
#pragma unroll
                    for (int r = 0; r < 16; ++r) o[d0][r] *= alpha; }
            bf16x8 pf[4]; pf[0] = packp8(p0, 0); pf[1] = packp8(p0, 1); pf[2] = packp8(p1, 0); pf[3] = packp8(p1, 1);
            __builtin_amdgcn_sched_barrier(0); ATT_LOADV(1, 1); __builtin_amdgcn_sched_barrier(0);
#pragma unroll
            for (int d0 = 0; d0 < 4; ++d0) {
#pragma unroll
                for (int s = 0; s < 4; ++s) o[d0] = MFMA32(cat44(fv[d0 & 1][2 * s], fv[d0 & 1][2 * s + 1]), pf[s], o[d0]);
                __builtin_amdgcn_sched_barrier(0);
                if (d0 + 2 < 4) { ATT_LOADV(d0 & 1, d0 + 2); __builtin_amdgcn_sched_barrier(0); } }
#undef ATT_LOADV
            }
        }
        ATT_WAITBAR(NKOPS);
    }
    asm volatile("s_waitcnt vmcnt(0)" ::: "memory");
#undef ATT_DMAK
#undef ATT_DMAV
#undef ATT_WAITBAR
    const float rl = 1.0f / l_run;
    bf16* orow = Op + ((size_t)b * SEQ + t) * opitch;
#pragma unroll
    for (int d0 = 0; d0 < 4; ++d0)
#pragma unroll
        for (int g4 = 0; g4 < 4; ++g4) { u32x2 wv; wv.x = pg8::cvt_pk_bf16(o[d0][4 * g4 + 0] * rl, o[d0][4 * g4 + 1] * rl); wv.y = pg8::cvt_pk_bf16(o[d0][4 * g4 + 2] * rl, o[d0][4 * g4 + 3] * rl);
            *(u32x2*)(orow + 32 * d0 + 8 * g4 + 4 * hi) = wv; }
    __syncthreads();
}

DEVI void ret_kv_unit(LAS unsigned char* lds, int bh, int c, const bf16* __restrict__ RK, const bf16* __restrict__ PROJ, float* __restrict__ KVC, float lg2) {
    constexpr int STR = 320;
    int tid_o = threadIdx.x; asm volatile("" : "+v"(tid_o));
    const int tid = tid_o, w = __builtin_amdgcn_readfirstlane(tid >> 6), lane = tid & 63, hi = lane >> 5;
    const int b = bh >> 3, h = bh & 7; const size_t m0 = (size_t)b * SEQ + (size_t)c * 128;
    LAS unsigned char* Kt = lds; LAS unsigned char* Vt = lds + 128 * STR;
    __syncthreads();
#pragma unroll
    for (int i = 0; i < 4; ++i) { const int ci = tid + 512 * i, row = ci >> 4, ch = ci & 15;
        const u32x4 kv = *(const u32x4*)(RK + (m0 + row) * 1024 + h * 128 + ch * 8); float f[8]; unpack8(kv, f); const float kd = __builtin_amdgcn_exp2f(lg2 * (float)(127 - row));
#pragma unroll
        for (int e = 0; e < 8; ++e) f[e] *= kd;
        *(LAS u32x4*)(Kt + row * STR + ch * 16) = pack8(f);
        *(LAS u32x4*)(Vt + row * STR + ch * 16) = *(const u32x4*)(PROJ + (m0 + row) * NINP + C_RV + h * 128 + ch * 8); }
    __syncthreads();
    const int eb = w & 3, dh = w >> 2, g = lane >> 4, q4 = (lane >> 2) & 3, p4 = lane & 3;
    const LAS unsigned char* abase = Vt + (4 * hi + q4) * STR + (32 * eb + 16 * (g & 1) + 4 * p4) * 2;
    const LAS unsigned char* bbase = Kt + (4 * hi + q4) * STR + (64 * dh + 16 * (g & 1) + 4 * p4) * 2;
    f32x16 acc[2];
#pragma unroll
    for (int r = 0; r < 16; ++r) { acc[0][r] = 0.f; acc[1][r] = 0.f; }
#pragma unroll
    for (int js = 0; js < 8; ++js) { const bf16x8 A = cat44(vtr(abase + (16 * js) * STR), vtr(abase + (16 * js + 8) * STR));
#pragma unroll
        for (int x = 0; x < 2; ++x) { const bf16x8 B = cat44(vtr(bbase + (16 * js) * STR + x * 64), vtr(bbase + (16 * js + 8) * STR + x * 64)); acc[x] = MFMA32(A, B, acc[x]); } }
    float* outp = KVC + ((size_t)(bh * 64 + c) * 128) * 128;
#pragma unroll
    for (int x = 0; x < 2; ++x)
#pragma unroll
        for (int r = 0; r < 16; ++r) outp[(size_t)(32 * eb + crow(r, hi)) * 128 + 64 * dh + 32 * x + (lane & 31)] = acc[x][r];
}

DEVI void ret_out_unit(LAS unsigned char* lds, int bh, int c, const bf16* __restrict__ RQ, const bf16* __restrict__ RK, const bf16* __restrict__ PROJ, const bf16* __restrict__ STB,
                       const float* __restrict__ gain, const float* __restrict__ bias, bf16* __restrict__ CAT, float lg2) {
    constexpr int KS = 272, VS = 320;
    int tid_o = threadIdx.x; asm volatile("" : "+v"(tid_o));
    const int tid = tid_o, w = __builtin_amdgcn_readfirstlane(tid >> 6), lane = tid & 63, r32 = lane & 31, hi = lane >> 5;
    const int b = bh >> 3, h = bh & 7; const size_t m0 = (size_t)b * SEQ + (size_t)c * 128;
    LAS unsigned char* Kt = lds; LAS unsigned char* Vt = lds + 128 * KS; LAS unsigned char* St = lds + 128 * KS + 128 * VS; LAS float* part = (LAS float*)(lds + 128 * KS + 128 * VS + 128 * KS);
    __syncthreads();
    const bf16* stsrc = STB + (size_t)(bh * 64 + c) * 16384;
#pragma unroll
    for (int i = 0; i < 4; ++i) { const int ci = tid + 512 * i, row = ci >> 4, ch = ci & 15;
        *(LAS u32x4*)(Kt + row * KS + ch * 16) = *(const u32x4*)(RK + (m0 + row) * 1024 + h * 128 + ch * 8);
        *(LAS u32x4*)(Vt + row * VS + ch * 16) = *(const u32x4*)(PROJ + (m0 + row) * NINP + C_RV + h * 128 + ch * 8);
        *(LAS u32x4*)(St + row * KS + ch * 16) = *(const u32x4*)(stsrc + row * 128 + ch * 8); }
    __syncthreads();
    const int ib = w & 3, eh = w >> 2, iloc = 32 * ib + r32; const size_t m = m0 + iloc;
    bf16x8 qf[8];
#pragma unroll
    for (int ds = 0; ds < 8; ++ds) qf[ds] = *(const bf16x8*)(RQ + m * 1024 + h * 128 + 16 * ds + 8 * hi);
    f32x16 o[2];
#pragma unroll
    for (int r = 0; r < 16; ++r) { o[0][r] = 0.f; o[1][r] = 0.f; }
    const int g = lane >> 4, q4 = (lane >> 2) & 3, p4 = lane & 3;
    const LAS unsigned char* vbase = Vt + (4 * hi + q4) * VS + (64 * eh + 16 * (g & 1) + 4 * p4) * 2;
    for (int jb = 0; jb <= ib; ++jb) {
        f32x16 p;
#pragma unroll
        for (int r = 0; r < 16; ++r) p[r] = 0.f;
        const LAS unsigned char* ka = Kt + (32 * jb + r32) * KS + hi * 16;
#pragma unroll
        for (int ds = 0; ds < 8; ++ds) p = MFMA32(*(const LAS bf16x8*)(ka + ds * 32), qf[ds], p);
#pragma unroll
        for (int r = 0; r < 16; ++r) { const int diff = iloc - (32 * jb + crow(r, hi)); p[r] = (diff >= 0) ? p[r] * __builtin_amdgcn_exp2f(lg2 * (float)diff) : 0.f; }
        const bf16x8 pf0 = packp8(p, 0), pf1 = packp8(p, 1);
        const LAS unsigned char* vb = vbase + (32 * jb) * VS;
#pragma unroll
        for (int x = 0; x < 2; ++x) {
            o[x] = MFMA32(cat44(vtr(vb + x * 64), vtr(vb + 8 * VS + x * 64)), pf0, o[x]);
            o[x] = MFMA32(cat44(vtr(vb + 16 * VS + x * 64), vtr(vb + 24 * VS + x * 64)), pf1, o[x]); }
    }
    {   f32x16 ca[2];
#pragma unroll
        for (int r = 0; r < 16; ++r) { ca[0][r] = 0.f; ca[1][r] = 0.f; }
        const LAS unsigned char* sa = St + (64 * eh + r32) * KS + hi * 16;
#pragma unroll
        for (int ds = 0; ds < 8; ++ds) { ca[0] = MFMA32(*(const LAS bf16x8*)(sa + ds * 32), qf[ds], ca[0]); ca[1] = MFMA32(*(const LAS bf16x8*)(sa + 32 * KS + ds * 32), qf[ds], ca[1]); }
        const float qd = __builtin_amdgcn_exp2f(lg2 * (float)(iloc + 1));
#pragma unroll
        for (int r = 0; r < 16; ++r) { o[0][r] += qd * ca[0][r]; o[1][r] += qd * ca[1][r]; } }
    float s1 = 0.f, s2 = 0.f;
#pragma unroll
    for (int r = 0; r < 16; ++r) { s1 += o[0][r] + o[1][r]; s2 += o[0][r] * o[0][r] + o[1][r] * o[1][r]; }
    s1 += __shfl_xor(s1, 32); s2 += __shfl_xor(s2, 32);
    if (hi == 0) { part[(eh * 128 + iloc) * 2] = s1; part[(eh * 128 + iloc) * 2 + 1] = s2; }
    __syncthreads();
    const float t1 = part[iloc * 2] + part[(128 + iloc) * 2], t2 = part[iloc * 2 + 1] + part[(128 + iloc) * 2 + 1];
    const float mu = t1 * (1.0f / 128.0f), var = fmaxf(t2 * (1.0f / 128.0f) - mu * mu, 0.f), rstd = 1.0f / sqrtf(var + LN_EPS);
    const bf16* grow = PROJ + m * NINP + C_RG + h * 128; bf16* orow = CAT + m * DM + h * 128;
#pragma unroll
    for (int x = 0; x < 2; ++x)
#pragma unroll
        for (int g4 = 0; g4 < 4; ++g4) { const int e0 = 64 * eh + 32 * x + 8 * g4 + 4 * hi;
            const f32x4 gn = *(const f32x4*)(gain + h * 128 + e0), bs = *(const f32x4*)(bias + h * 128 + e0); const u32x2 gw = *(const u32x2*)(grow + e0);
            const float gg[4] = {__uint_as_float(gw.x << 16), __uint_as_float(gw.x & 0xffff0000u), __uint_as_float(gw.y << 16), __uint_as_float(gw.y & 0xffff0000u)};
            float y[4];
#pragma unroll
            for (int e = 0; e < 4; ++e) y[e] = ((o[x][4 * g4 + e] - mu) * rstd * gn[e] + bs[e]) * (gg[e] * sigm(gg[e]));
            u32x2 wv; wv.x = pg8::cvt_pk_bf16(y[0], y[1]); wv.y = pg8::cvt_pk_bf16(y[2], y[3]); *(u32x2*)(orow + e0) = wv; }
}

struct Args { const void* in[35]; float* out; unsigned char* ws; int ph_lo, ph_hi; };
constexpr int NPH_LAYER = 16, NPHASES = 1 + DEPTH * NPH_LAYER;

__global__ void __launch_bounds__(NTHR, 2) fwd_kernel(Args args) {
    extern __shared__ __attribute__((aligned(16))) unsigned char lds_raw[];
    LAS unsigned char* lds = (LAS unsigned char*)lds_raw;
    const int G = gridDim.x, bid = blockIdx.x, NGW = G * NWAVES;
#define PHASE_IDS() int tid = threadIdx.x; asm volatile("" : "+v"(tid)); const int lane = tid & 63, wave = __builtin_amdgcn_readfirstlane(tid >> 6), gw = bid * NWAVES + wave; (void)lane; (void)gw
    volatile LAS unsigned* MISC = (volatile LAS unsigned*)(lds + LDSCTL_OFF);
    volatile LAS unsigned long long* TAB = (volatile LAS unsigned long long*)(lds + LDSCTL_OFF + 1024);
    { PHASE_IDS();
      for (int u = tid; u < (LDS_BYTES - LDSCTL_OFF) / 4; u += NTHR) ((LAS unsigned*)(lds + LDSCTL_OFF))[u] = 0u;
      __syncthreads();
      if (tid == 0) {
#define TSET(i) TAB[i] = (unsigned long long)args.in[i];
        TSET(0) TSET(1) TSET(2) TSET(3) TSET(4) TSET(5) TSET(6) TSET(7) TSET(8) TSET(9) TSET(10) TSET(11) TSET(12) TSET(13) TSET(14) TSET(15) TSET(16) TSET(17)
        TSET(18) TSET(19) TSET(20) TSET(21) TSET(22) TSET(23) TSET(24) TSET(25) TSET(26) TSET(27) TSET(28) TSET(29) TSET(30) TSET(31) TSET(32) TSET(33) TSET(34)
#undef TSET
        TAB[35] = (unsigned long long)args.out; TAB[36] = (unsigned long long)args.ws; }
      __syncthreads(); }
#define INP(i) ((const float*)rfl64(TAB[i]))
#define WSP(T, off) ((T*)((unsigned char*)rfl64(TAB[36]) + (off)))
#define HBUF() ((float*)rfl64(TAB[35]))
    XcdBarrier bar; bar.bar = (unsigned*)WSP(unsigned, WS_CTL + CW_BAR * 4); bar.x = 0; bar.st = nullptr;
    if (!MK_SPLIT) bar = xcd_barrier_post((unsigned*)WSP(unsigned, WS_CTL + CW_BAR * 4), MISC + 8);
    const int lo = args.ph_lo, hi_ph = args.ph_hi;
#define IN(k) (lo <= (k) && (k) < hi_ph)
#ifndef MK_MASK
#define MK_MASK 0xffff
#endif
#define EN(b) ((MK_MASK >> (b)) & 1)
#ifndef MK_DUP
#define MK_DUP 0
#endif
#define DUP(b) ((MK_DUP >> (b)) & 1)
#define SEAM(k) do { if (IN(k) && IN((k) + 1)) xcd_barrier(bar); } while (0)

    if (EN(0) && IN(0)) { PHASE_IDS();
        const int gt = bid * NTHR + tid, NGT = G * NTHR;
        const float* x = INP(0); const float* p_in = INP(1); const int* positions = (const int*)INP(2); float* hbuf = HBUF();
        float* COS128 = WSP(float, WS_COS128); float* SIN128 = WSP(float, WS_SIN128); float* COS64 = WSP(float, WS_COS64); float* SIN64 = WSP(float, WS_SIN64); bf16* P16 = WSP(bf16, WS_P16); float* RS = WSP(float, WS_RS);
        for (int idx = gt; idx < M * 64; idx += NGT) { const int m = idx >> 6, i = idx & 63; float s, c; sincos_d((float)positions[m] * inv_freq(i, 0.8659643233600653), s, c); COS128[idx] = c; SIN128[idx] = s; }
        for (int idx = gt; idx < M * 32; idx += NGT) { const int m = idx >> 5, i = idx & 31; float s, c; sincos_d((float)positions[m] * inv_freq(i, 0.7498942093324559), s, c); COS64[idx] = c; SIN64[idx] = s; }
        for (int idx = gt; idx < DEPTH * M * 256 / 4; idx += 4 * NGT) { f32x4 v[4];
#pragma unroll
            for (int u = 0; u < 4; ++u) v[u] = (idx + u * NGT < DEPTH * M * 256 / 4) ? ((const f32x4*)p_in)[idx + u * NGT] : (f32x4){0.f, 0.f, 0.f, 0.f};
#pragma unroll
            for (int u = 0; u < 4; ++u) if (idx + u * NGT < DEPTH * M * 256 / 4) { u32x2 o; o.x = pk2(v[u].x, v[u].y); o.y = pk2(v[u].z, v[u].w); ((u32x2*)P16)[idx + u * NGT] = o; } }
        const float* g0 = INP(3);
        bf16* H16 = WSP(bf16, WS_H16);
        for (int m = gw; m < M; m += NGW) norm_row<true, false, true>(x + (size_t)m * DM, H16 + (size_t)m * DM, nullptr, 0.f, g0, RS + m, lane);
    }

    for (int L = 0; L < DEPTH; ++L) {
        const int pb = 1 + L * NPH_LAYER;
        for (int rep_ = 0; rep_ < (DUP(1) ? 2 : 1); ++rep_) if (EN(1) && IN(pb + 0)) { PHASE_IDS();
            LAS float* scr = (LAS float*)(lds + wave * 16384);
            bf16* W_GU1 = WSP(bf16, WS_WGU1); bf16* W_GU2 = WSP(bf16, WS_WGU2); bf16* W_D1 = WSP(bf16, WS_WD1); bf16* W_D2 = WSP(bf16, WS_WD2); bf16* W_IN = WSP(bf16, WS_WIN); bf16* W_OUT = WSP(bf16, WS_WOUT);
            bf16* W_PG = WSP(bf16, WS_WPG); bf16* W_PP = WSP(bf16, WS_WPP); bf16* W_UQ = WSP(bf16, WS_WUQ); bf16* W_UKV = WSP(bf16, WS_WUKV); bf16* W_PW = WSP(bf16, WS_WPW);
            constexpr int I_F = 22016, I_IN = 64 * 344, I_SQ = 64 * 128, I_PP = 4 * 128, I_UQ = 16 * 48, I_UKV = 8 * 64, I_PW = 16 * 32;
            constexpr int NITEMS = 6 * I_F + I_IN + 2 * I_SQ + I_PP + I_UQ + I_UKV + I_PW;
            const size_t oF = (size_t)L * DM * DFF;
            for (int it = gw; it < NITEMS; it += NGW) {
                int r = it;
                if (r < 6 * I_F) { const int seg = r / I_F; r -= seg * I_F; const int f = seg / 3, kind = seg % 3;
                    const float* Wsrc = (const float*)(f ? (kind == 0 ? INP(27) : kind == 1 ? INP(28) : INP(29)) : (kind == 0 ? INP(4) : kind == 1 ? INP(5) : INP(6))) + oF;
                    if (kind < 2) { const int kb = r / 344, nb = r % 344, n0 = nb * 32; tr_item(Wsrc, DM, DFF, (f ? W_GU2 : W_GU1), (n0 >> 7) * 256 + (n0 & 127) + kind * 128, scr, kb * 64, n0, lane, (const float*)(f ? INP(26) : INP(3)) + (size_t)L * DM); }
                    else { const int kb = r / 128, nb = r % 128; tr_item(Wsrc, DFF, DM, (f ? W_D2 : W_D1), nb * 32, scr, kb * 64, nb * 32, lane); }
                    continue; }
                r -= 6 * I_F;
                if (r < I_IN) { const int kb = r / 344, nb = r % 344; tr_item(INP(9) + (size_t)L * DM * NIN, DM, NIN, W_IN, nb * 32, scr, kb * 64, nb * 32, lane, INP(8) + (size_t)L * DM); continue; } r -= I_IN;
                if (r < I_SQ) { const int kb = r / 128, nb = r % 128; tr_item(INP(24) + (size_t)L * DM * DM, DM, DM, W_OUT, nb * 32, scr, kb * 64, nb * 32, lane); continue; } r -= I_SQ;
                if (r < I_SQ) { const int kb = r / 128, nb = r % 128; tr_item(INP(32) + (size_t)L * DM * DM, DM, DM, W_PG, nb * 32, scr, kb * 64, nb * 32, lane, INP(31) + (size_t)L * DM); continue; } r -= I_SQ;
                if (r < I_PP) { const int kb = r / 128, nb = r % 128; tr_item(INP(33) + (size_t)L * 256 * DM, 256, DM, W_PP, nb * 32, scr, kb * 64, nb * 32, lane); continue; } r -= I_PP;
                if (r < I_UQ) { const int kb = r / 48, nb = r % 48; tr_item(INP(11) + (size_t)L * 1024 * 1536, 1024, 1536, W_UQ, nb * 32, scr, kb * 64, nb * 32, lane); continue; } r -= I_UQ;
                if (r < I_UKV) { const int kb = r / 64, nb = r % 64; tr_item(INP(13) + (size_t)L * 512 * 2048, 512, 2048, W_UKV, nb * 32, scr, kb * 64, nb * 32, lane); continue; } r -= I_UKV;
                { const int kb = r / 32, nb = r % 32; tr_item(INP(22) + (size_t)L * 1024 * 1024, 1024, 1024, W_PW, nb * 32, scr, kb * 64, nb * 32, lane); }
            }
        }
        SEAM(pb + 0);

        for (int half = 0; half < 2; ++half) {
            const int fa = pb + (half ? 11 : 1);
            for (int rep_ = 0; rep_ < (DUP(2) ? 2 : 1); ++rep_) if (EN(2) && IN(fa)) { PHASE_IDS(); pg8::Gemm g{WSP(bf16, WS_H16), half ? WSP(bf16, WS_WGU2) : WSP(bf16, WS_WGU1), M, 2 * DFF, DM}; pg8::StaticOrder S; S.init(M, 2 * DFF, G, bid, 8); pg8::EpiSwiglu E{WSP(bf16, WS_ACT), DFF, WSP(float, WS_RS)};
                pg8::gemm_phase<pg8::EpiSwiglu, pg8::StaticOrder, true, true>(lds, g, S, E);
                if (half == 0) { const int nshort = (5504 % G) ? G - (5504 % G) : G; const int first = G - nshort;
                    if (bid >= first) { pg8::Gemm g2{WSP(bf16, WS_P16) + (size_t)L * M * 256, WSP(bf16, WS_WPP), M, DM, 256}; pg8::StaticOrder S2; S2.init(M, DM, nshort, bid - first); pg8::EpiBf16P E2{WSP(bf16, WS_PPB), DM, nullptr, nullptr};
                        pg8::gemm_phase<pg8::EpiBf16P, pg8::StaticOrder, true, true>(lds, g2, S2, E2); } } }
            SEAM(fa);
            for (int rep_ = 0; rep_ < (DUP(3) ? 2 : 1); ++rep_) if (EN(3) && IN(fa + 1)) { PHASE_IDS(); pg8::Gemm g{WSP(bf16, WS_ACT), half ? WSP(bf16, WS_WD2) : WSP(bf16, WS_WD1), M, DM, DFF}; pg8::StaticOrder S; S.init(M, DM, G, bid); pg8::EpiBf16P E{WSP(bf16, WS_Y), DM, nullptr, nullptr};
                pg8::gemm_phase<pg8::EpiBf16P, pg8::StaticOrder, true, true>(lds, g, S, E); }
            SEAM(fa + 1);
            for (int rep_ = 0; rep_ < (DUP(4) ? 2 : 1); ++rep_) if (EN(4) && IN(fa + 2)) { PHASE_IDS(); float* hbuf = HBUF(); const bf16* Y = WSP(bf16, WS_Y); float* RS = WSP(float, WS_RS);
                const float* gpost = (const float*)(half ? INP(30) : INP(7)) + (size_t)L * DM; const float* gpre = (const float*)(half ? INP(31) : INP(8)) + (size_t)L * DM;
                bf16* H16 = WSP(bf16, WS_H16);
                { f32x4 gr[16];
_Pragma("unroll") for (int j = 0; j < 16; ++j) gr[j] = ((const f32x4*)gpost)[lane + 64 * j];
 for (int m = gw; m < M; m += NGW) norm_row<false, false, true, true>(H16 + (size_t)m * DM, H16 + (size_t)m * DM, Y + (size_t)m * DM, rep_ ? 0.f : 0.5f, gpost, RS + m, lane, gr); }
            }
            SEAM(fa + 2);

            if (half == 0) {
                for (int rep_ = 0; rep_ < (DUP(5) ? 2 : 1); ++rep_) if (EN(5) && IN(pb + 4)) { PHASE_IDS(); pg8::Gemm g{WSP(bf16, WS_H16), WSP(bf16, WS_WIN), M, NINP, DM}; pg8::StaticOrder S; S.init(M, NINP, G, bid); pg8::EpiBf16P E{WSP(bf16, WS_ACT), NINP, nullptr, WSP(float, WS_RS)};
                    pg8::gemm_phase<pg8::EpiBf16P, pg8::StaticOrder, true, true>(lds, g, S, E); }
                SEAM(pb + 4);
                for (int rep_ = 0; rep_ < (DUP(6) ? 2 : 1); ++rep_) if (EN(6) && IN(pb + 5)) { PHASE_IDS();
                    const bf16* PROJ = WSP(bf16, WS_ACT); const float* COS128 = WSP(float, WS_COS128); const float* SIN128 = WSP(float, WS_SIN128); const float* COS64 = WSP(float, WS_COS64); const float* SIN64 = WSP(float, WS_SIN64);
                    bf16* RQ = WSP(bf16, WS_RQ); bf16* RK = WSP(bf16, WS_RK); bf16* CQN = WSP(bf16, WS_CQN); bf16* CKVN = WSP(bf16, WS_CKVN); bf16* KR = WSP(bf16, WS_KR); float* LOGF = WSP(float, WS_LOGF); bf16* U = WSP(bf16, WS_U);
                    const float* qn = INP(10) + L * 1024; const float* kvn = INP(12) + L * 512; const float* fb = INP(16) + L * 8; const float* gb = INP(17) + L * 2048;
                    float mq0 = 0.f, mq1 = 0.f, mk0 = 0.f, mk1 = 0.f;
                    float qn0[8], qn1[8], kvn0[8], gba[2][8], gbg[2][8];
#pragma unroll
                    for (int e = 0; e < 8; ++e) { qn0[e] = qn[lane * 8 + e]; qn1[e] = qn[512 + lane * 8 + e]; kvn0[e] = kvn[lane * 8 + e];
                        gba[0][e] = gb[lane * 8 + e]; gba[1][e] = gb[512 + lane * 8 + e]; gbg[0][e] = gb[1024 + lane * 8 + e]; gbg[1][e] = gb[1536 + lane * 8 + e]; }
                    for (int m = gw; m < M; m += NGW) {
                        const bf16* pr = PROJ + (size_t)m * NINP; const int b = m >> 13, t = m & (SEQ - 1);
                        const int l16 = lane & 15, hq = lane >> 4;
                        u32x2 qa[2], qb[2], ka[2], kb[2];
#pragma unroll
                        for (int g = 0; g < 2; ++g) { const int ho = (4 * g + hq) * 128 + 4 * l16;
                            qa[g] = *(const u32x2*)(pr + C_RQ + ho); qb[g] = *(const u32x2*)(pr + C_RQ + ho + 64); ka[g] = *(const u32x2*)(pr + C_RK + ho); kb[g] = *(const u32x2*)(pr + C_RK + ho + 64); }
                        const f32x4 c4 = *(const f32x4*)(COS128 + m * 64 + 4 * l16), s4 = *(const f32x4*)(SIN128 + m * 64 + 4 * l16);
                        const u32x4 cq0 = *(const u32x4*)(pr + C_CQ + lane * 8), cq1 = *(const u32x4*)(pr + C_CQ + 512 + lane * 8), ckv = *(const u32x4*)(pr + C_CKV + lane * 8);
                        const u32x4 fq0 = *(const u32x4*)(pr + C_FQ + lane * 16), fq1 = *(const u32x4*)(pr + C_FQ + lane * 16 + 8), fk0 = *(const u32x4*)(pr + C_FK + lane * 16), fk1 = *(const u32x4*)(pr + C_FK + lane * 16 + 8);
                        const u32x4 ca0 = *(const u32x4*)(pr + C_CIN + lane * 8), ca1 = *(const u32x4*)(pr + C_CIN + 512 + lane * 8), cg0 = *(const u32x4*)(pr + C_CIN + 1024 + lane * 8), cg1 = *(const u32x4*)(pr + C_CIN + 1536 + lane * 8);
                        float c64 = 0.f, s64 = 0.f; unsigned short kr1 = 0, kr2 = 0, ffr = 0;
                        if (lane < 32) { c64 = COS64[m * 32 + lane]; s64 = SIN64[m * 32 + lane]; kr1 = pr[C_KR + lane]; kr2 = pr[C_KR + 32 + lane]; }
                        if (lane < 8) ffr = pr[C_FF + lane];
                        {
#pragma unroll
                          for (int g = 0; g < 2; ++g) { const size_t oo = (size_t)m * 1024 + (4 * g + hq) * 128 + 4 * l16;
                              const f32x4 q1 = {__uint_as_float(qa[g].x << 16), __uint_as_float(qa[g].x & 0xffff0000u), __uint_as_float(qa[g].y << 16), __uint_as_float(qa[g].y & 0xffff0000u)};
                              const f32x4 q2 = {__uint_as_float(qb[g].x << 16), __uint_as_float(qb[g].x & 0xffff0000u), __uint_as_float(qb[g].y << 16), __uint_as_float(qb[g].y & 0xffff0000u)};
                              const f32x4 k1 = {__uint_as_float(ka[g].x << 16), __uint_as_float(ka[g].x & 0xffff0000u), __uint_as_float(ka[g].y << 16), __uint_as_float(ka[g].y & 0xffff0000u)};
                              const f32x4 k2 = {__uint_as_float(kb[g].x << 16), __uint_as_float(kb[g].x & 0xffff0000u), __uint_as_float(kb[g].y << 16), __uint_as_float(kb[g].y & 0xffff0000u)};
                              const f32x4 qo1 = q1 * c4 - q2 * s4, qo2 = q2 * c4 + q1 * s4, ko1 = (k1 * c4 - k2 * s4) * 0.08838834764831845f, ko2 = (k2 * c4 + k1 * s4) * 0.08838834764831845f;
                              u32x2 w; w.x = pk2(qo1.x, qo1.y); w.y = pk2(qo1.z, qo1.w); *(u32x2*)(RQ + oo) = w; w.x = pk2(qo2.x, qo2.y); w.y = pk2(qo2.z, qo2.w); *(u32x2*)(RQ + oo + 64) = w;
                              w.x = pk2(ko1.x, ko1.y); w.y = pk2(ko1.z, ko1.w); *(u32x2*)(RK + oo) = w; w.x = pk2(ko2.x, ko2.y); w.y = pk2(ko2.z, ko2.w); *(u32x2*)(RK + oo + 64) = w; } }
                        { float f0[8], f1[8]; unpack8(cq0, f0); unpack8(cq1, f1); float ss = 0.f;
#pragma unroll
                          for (int e = 0; e < 8; ++e) ss += f0[e] * f0[e] + f1[e] * f1[e];
                          const float rs = 1.0f / sqrtf(wave_sum(ss) * (1.0f / 1024.0f) + NORM_EPS);
#pragma unroll
                          for (int e = 0; e < 8; ++e) { f0[e] *= rs * qn0[e]; f1[e] *= rs * qn1[e]; }
                          *(u32x4*)(CQN + (size_t)m * 1024 + lane * 8) = pack8(f0); *(u32x4*)(CQN + (size_t)m * 1024 + 512 + lane * 8) = pack8(f1); }
                        { float f0[8]; unpack8(ckv, f0); float ss = 0.f;
#pragma unroll
                          for (int e = 0; e < 8; ++e) ss += f0[e] * f0[e];
                          const float rs = 1.0f / sqrtf(wave_sum(ss) * (1.0f / 512.0f) + NORM_EPS);
#pragma unroll
                          for (int e = 0; e < 8; ++e) f0[e] *= rs * kvn0[e];
                          *(u32x4*)(CKVN + (size_t)m * 512 + lane * 8) = pack8(f0); }
                        if (lane < 32) { const float x1 = bf2f(kr1), x2 = bf2f(kr2);
                            KR[(size_t)m * 64 + lane] = (bf16)f2bf(x1 * c64 - x2 * s64); KR[(size_t)m * 64 + 32 + lane] = (bf16)f2bf(x2 * c64 + x1 * s64); }
                        { float fq[8], fk[8]; float sq = 0.f, sk = 0.f;
                          unpack8(fq0, fq); unpack8(fk0, fk);
#pragma unroll
                          for (int e = 0; e < 8; ++e) { sq += fq[e] * fq[e]; sk += fk[e] * fk[e]; }
                          unpack8(fq1, fq); unpack8(fk1, fk);
#pragma unroll
                          for (int e = 0; e < 8; ++e) { sq += fq[e] * fq[e]; sk += fk[e] * fk[e]; }
                          sq += __shfl_xor(sq, 1); sq += __shfl_xor(sq, 2); sq += __shfl_xor(sq, 4); sk += __shfl_xor(sk, 1); sk += __shfl_xor(sk, 2); sk += __shfl_xor(sk, 4);
                          if (b) { mq1 = fmaxf(mq1, sq); mk1 = fmaxf(mk1, sk); } else { mq0 = fmaxf(mq0, sq); mk0 = fmaxf(mk0, sk); } }
                        if (lane < 8) { const float xv = bf2f(ffr) + fb[lane]; LOGF[(size_t)(b * 8 + lane) * SEQ + t] = fminf(xv, 0.f) - __logf(1.0f + __expf(-fabsf(xv))); }
                        {
#pragma unroll
                          for (int hf = 0; hf < 2; ++hf) { const int c0 = hf * 512 + lane * 8; float a[8], gt_[8]; unpack8(hf ? ca1 : ca0, a); unpack8(hf ? cg1 : cg0, gt_);
#pragma unroll
                              for (int e = 0; e < 8; ++e) a[e] = (a[e] + gba[hf][e]) * sigm(gt_[e] + gbg[hf][e]);
                              *(u32x4*)(U + (size_t)m * 1024 + c0) = pack8(a); } }
                    }
                    {
                        LAS float* part = (LAS float*)lds;
                        if ((lane & 7) == 0) { const int h = lane >> 3; LAS float* pw = part + wave * 32; pw[(0 * 8 + h) * 2] = mq0; pw[(0 * 8 + h) * 2 + 1] = mk0; pw[(1 * 8 + h) * 2] = mq1; pw[(1 * 8 + h) * 2 + 1] = mk1; }
                        __syncthreads();
                        if (tid < 32) { float v = part[tid];
#pragma unroll
                            for (int ww = 1; ww < 8; ++ww) v = fmaxf(v, part[ww * 32 + tid]);
                            WSP(float, WS_CTL + CW_QK * 4)[(size_t)L * 32768 + bid * 32 + tid] = v; }
                        __syncthreads(); }
                }
                SEAM(pb + 5);
                for (int rep_ = 0; rep_ < (DUP(7) ? 2 : 1); ++rep_) if (EN(7) && IN(pb + 6)) { PHASE_IDS();
                    const float* LOGF = WSP(float, WS_LOGF); float* CUM2 = WSP(float, WS_CUM2);
                    if (bid < 16) {
                        LAS double* sc = (LAS double*)lds;
                        const float* src = LOGF + (size_t)bid * SEQ + tid * 16; float v[16];
#pragma unroll
                        for (int e = 0; e < 4; ++e) { const f32x4 q = ((const f32x4*)src)[e]; v[4 * e] = q.x; v[4 * e + 1] = q.y; v[4 * e + 2] = q.z; v[4 * e + 3] = q.w; }
                        double tot = 0.0;
#pragma unroll
                        for (int e = 0; e < 16; ++e) tot += (double)v[e];
                        double inc = tot;
#pragma unroll
                        for (int o = 1; o < 64; o <<= 1) { const double nb = __shfl_up(inc, o); if (lane >= o) inc += nb; }
                        if (lane == 63) sc[wave] = inc;
                        __syncthreads();
                        double base = inc - tot;
                        for (int ww = 0; ww < wave; ++ww) base += sc[ww];
                        float* dst = CUM2 + (size_t)bid * SEQ + tid * 16;
#pragma unroll
                        for (int e = 0; e < 16; ++e) { base += (double)v[e]; dst[e] = (float)(base * 1.4426950408889634074); }
                        __syncthreads();
                    }
                    { pg8::Gemm g{WSP(bf16, WS_CQN), WSP(bf16, WS_WUQ), M, 1536, 1024}; pg8::StaticOrder S; S.init(M, 1536, G, bid); pg8::EpiBf16P E{WSP(bf16, WS_MQ), 1536, nullptr, nullptr};
                      pg8::gemm_phase<pg8::EpiBf16P, pg8::StaticOrder, true, true>(lds, g, S, E); }
                    { pg8::Gemm g{WSP(bf16, WS_CKVN), WSP(bf16, WS_WUKV), M, 2048, 512}; pg8::StaticOrder S; S.init(M, 2048, G, bid); pg8::EpiBf16P E{WSP(bf16, WS_KVR), 2048, nullptr, nullptr};
                      pg8::gemm_phase<pg8::EpiBf16P, pg8::StaticOrder, true, true>(lds, g, S, E); }
                    {
                        const bf16* U = WSP(bf16, WS_U); bf16* YC = WSP(bf16, WS_YC);
                        const float* dw = INP(18) + (size_t)L * 31 * 1024; const float* dwb = INP(19) + L * 1024;
                        const float* lng = INP(20) + L * 1024; const float* lnb = INP(21) + L * 1024;
                        for (int grp = gw; grp < M / 4; grp += NGW) { const int m0 = grp * 4, t0 = m0 & (SEQ - 1);
                            float acc[4][16]; f32x4 wt[4][4];
#pragma unroll
                            for (int o = 0; o < 4; ++o)
#pragma unroll
                                for (int e = 0; e < 16; ++e) acc[o][e] = 0.f;
#pragma unroll
                            for (int s = 0; s < 4; ++s)
#pragma unroll
                                for (int q = 0; q < 4; ++q) wt[s][q] = (f32x4){0.f, 0.f, 0.f, 0.f};
#pragma unroll 1
                            for (int qq = 0; qq < 9; ++qq) {
#pragma unroll
                                for (int s = 0; s < 4; ++s) { const int ri = 4 * qq + s;
                                    if (s & 1) asm volatile("" ::: "memory");
                                    if (ri <= 33) {
                                        if (ri <= 30) {
#pragma unroll
                                            for (int hf = 0; hf < 2; ++hf) { wt[s][2 * hf] = *(const f32x4*)(dw + ri * 1024 + hf * 512 + lane * 8); wt[s][2 * hf + 1] = *(const f32x4*)(dw + ri * 1024 + hf * 512 + lane * 8 + 4); } }
                                        const int tt = t0 - 30 + ri;
                                        if (tt >= 0) { float ua[8], ub[8]; const bf16* ur = U + (size_t)(m0 - 30 + ri) * 1024;
                                            unpack8(*(const u32x4*)(ur + lane * 8), ua); unpack8(*(const u32x4*)(ur + 512 + lane * 8), ub);
#pragma unroll
                                            for (int o = 0; o < 4; ++o) { const int j = ri - o;
                                                if (j >= 0 && j <= 30) { const int ws = (s - o) & 3;
#pragma unroll
                                                    for (int e = 0; e < 4; ++e) { acc[o][e] += ua[e] * wt[ws][0][e]; acc[o][4 + e] += ua[4 + e] * wt[ws][1][e]; acc[o][8 + e] += ub[e] * wt[ws][2][e]; acc[o][12 + e] += ub[4 + e] * wt[ws][3][e]; } } } } } } }
#pragma unroll
                            for (int o = 0; o < 4; ++o) { const int m = m0 + o; float s1 = 0.f;
#pragma unroll
                                for (int hf = 0; hf < 2; ++hf)
#pragma unroll
                                    for (int e = 0; e < 8; ++e) { acc[o][hf * 8 + e] += dwb[hf * 512 + lane * 8 + e]; s1 += acc[o][hf * 8 + e]; }
                                const float mu = wave_sum(s1) * (1.0f / 1024.0f); float s2 = 0.f;
#pragma unroll
                                for (int e = 0; e < 16; ++e) { acc[o][e] -= mu; s2 += acc[o][e] * acc[o][e]; }
                                const float rstd = 1.0f / sqrtf(wave_sum(s2) * (1.0f / 1024.0f) + LN_EPS);
#pragma unroll
                                for (int hf = 0; hf < 2; ++hf) { const int c0 = hf * 512 + lane * 8; float o8[8];
#pragma unroll
                                    for (int e = 0; e < 8; ++e) { const float yv = acc[o][hf * 8 + e] * rstd * lng[c0 + e] + lnb[c0 + e]; o8[e] = yv * sigm(yv); }
                                    *(u32x4*)(YC + (size_t)m * 1024 + c0) = pack8(o8); } } }
                    }
                    asm volatile("s_waitcnt vmcnt(0)" ::: "memory");
                    { const bf16* RK = WSP(bf16, WS_RK); const bf16* PROJ = WSP(bf16, WS_ACT); float* KVC = WSP(float, WS_KVC);
                      for (int u = bid; u < 1024; u += G) { const int bh = u >> 6, c = u & 63; ret_kv_unit(lds, bh, c, RK, PROJ, KVC, ret_lg2(bh & 7)); } }
                    __syncthreads();
                }
                SEAM(pb + 6);
                if (EN(8) && IN(pb + 7)) { PHASE_IDS();
                    { pg8::Gemm g{WSP(bf16, WS_YC), WSP(bf16, WS_WPW), M, 1024, 1024}; pg8::StaticOrder S; S.init(M, 1024, G, bid); pg8::EpiBf16P E{WSP(bf16, WS_CAT) + 3072, DM, INP(23) + L * 1024, nullptr};
                      pg8::gemm_phase<pg8::EpiBf16P, pg8::StaticOrder, true, true>(lds, g, S, E); }
                    bf16* MQ = WSP(bf16, WS_MQ); const float* COS64 = WSP(float, WS_COS64); const float* SIN64 = WSP(float, WS_SIN64); const float* KVC = WSP(float, WS_KVC); bf16* STB = WSP(bf16, WS_ST);
                    for (int m = gw; m < M; m += NGW) { const int hh = lane >> 3, i4 = (lane & 7) * 4; bf16* qp = MQ + (size_t)m * 1536 + hh * 192 + 128 + i4;
                        const u32x2 xa = *(const u32x2*)qp, xb = *(const u32x2*)(qp + 32); const f32x4 cc = *(const f32x4*)(COS64 + m * 32 + i4), sn = *(const f32x4*)(SIN64 + m * 32 + i4);
                        const f32x4 x1 = {__uint_as_float(xa.x << 16), __uint_as_float(xa.x & 0xffff0000u), __uint_as_float(xa.y << 16), __uint_as_float(xa.y & 0xffff0000u)};
                        const f32x4 x2 = {__uint_as_float(xb.x << 16), __uint_as_float(xb.x & 0xffff0000u), __uint_as_float(xb.y << 16), __uint_as_float(xb.y & 0xffff0000u)};
                        const f32x4 o1 = x1 * cc - x2 * sn, o2 = x2 * cc + x1 * sn;
                        u32x2 w; w.x = pk2(o1.x, o1.y); w.y = pk2(o1.z, o1.w); *(u32x2*)qp = w; w.x = pk2(o2.x, o2.y); w.y = pk2(o2.z, o2.w); *(u32x2*)(qp + 32) = w; }
                    for (int idx = bid * NTHR + tid; idx < 16 * 8192; idx += G * NTHR) { const int bh = idx >> 13, ed = (idx & 8191) * 2; const float cd = __builtin_amdgcn_exp2f(ret_lg2(bh & 7) * 128.0f);
                        const float* kp = KVC + (size_t)bh * 64 * 16384 + ed; bf16* sp = STB + (size_t)bh * 64 * 16384 + ed; float S0 = 0.f, S1 = 0.f;
                        for (int cb = 0; cb < 64; cb += 16) { float kv0[16], kv1[16];
#pragma unroll
                            for (int c = 0; c < 16; ++c) { kv0[c] = kp[(size_t)(cb + c) * 16384]; kv1[c] = kp[(size_t)(cb + c) * 16384 + 1]; }
#pragma unroll
                            for (int c = 0; c < 16; ++c) { *(unsigned*)(sp + (size_t)(cb + c) * 16384) = pk2(S0, S1); S0 = S0 * cd + kv0[c]; S1 = S1 * cd + kv1[c]; } } }
                }
                SEAM(pb + 7);
                for (int rep_ = 0; rep_ < (DUP(9) ? 2 : 1); ++rep_) if (EN(9) && IN(pb + 8)) { PHASE_IDS();
                    asm volatile("s_waitcnt vmcnt(0)" ::: "memory"); __syncthreads();
                    const bf16* MQ = WSP(bf16, WS_MQ); const bf16* KVR = WSP(bf16, WS_KVR); const bf16* KR = WSP(bf16, WS_KR); const bf16* PROJ = WSP(bf16, WS_ACT); const float* CUM2 = WSP(float, WS_CUM2); bf16* CAT = WSP(bf16, WS_CAT);
                    const bf16* RQ = WSP(bf16, WS_RQ); const bf16* RK = WSP(bf16, WS_RK); const bf16* STB = WSP(bf16, WS_ST); const float* QKP = WSP(float, WS_CTL + CW_QK * 4) + (size_t)L * 32768;
                    for (int k = bid; k < 512; k += G) { const int i = (k < 256) ? k : 767 - k; const int qb = 31 - (i >> 4), bh = i & 15, b = bh >> 3, h = bh & 7;
                        attn_unit<192, false>(lds, b, qb, MQ + h * 192, 1536, KVR + h * 256, 2048, KR, 64, KVR + h * 256 + 128, 2048, nullptr, CAT + 1024 + h * 128, DM, 0.07216878364870323f * LOG2E, 0.f); }
                    for (int k = bid; k < 512; k += G) { const int i = (k < 256) ? k : 767 - k; const int qb = 31 - (i >> 4), bh = i & 15, b = bh >> 3, h = bh & 7;
                        float mq = 0.f, mk = 0.f; int ln_ = threadIdx.x; asm volatile("" : "+v"(ln_)); for (int blk = ln_ & 63; blk < G; blk += 64) { mq = fmaxf(mq, QKP[blk * 32 + bh * 2]); mk = fmaxf(mk, QKP[blk * 32 + bh * 2 + 1]); }
                        mq = wave_max(mq); mk = wave_max(mk);
                        const float qkm = sqrtf(mq * mk) * (0.08838834764831845f * LOG2E);
                        attn_unit<128, true>(lds, b, qb, PROJ + C_FQ + h * 128, NINP, PROJ + C_FK + h * 128, NINP, nullptr, 0, PROJ + C_FV + h * 128, NINP, CUM2 + (size_t)bh * SEQ, CAT + 2048 + h * 128, DM, 0.08838834764831845f * LOG2E, qkm); }
                    const float* gg = INP(14) + L * 1024; const float* gbias = INP(15) + L * 1024;
                    for (int u = bid; u < 1024; u += G) { const int bh = u >> 6, c = u & 63; ret_out_unit(lds, bh, c, RQ, RK, PROJ, STB, gg, gbias, CAT, ret_lg2(bh & 7)); }
                    __syncthreads();
                }
                SEAM(pb + 8);
                for (int rep_ = 0; rep_ < (DUP(10) ? 2 : 1); ++rep_) if (EN(10) && IN(pb + 9)) { PHASE_IDS(); pg8::Gemm g{WSP(bf16, WS_CAT), WSP(bf16, WS_WOUT), M, DM, DM}; pg8::StaticOrder S; S.init(M, DM, G, bid); pg8::EpiBf16P E{WSP(bf16, WS_Y), DM, nullptr, nullptr};
                    pg8::gemm_phase<pg8::EpiBf16P, pg8::StaticOrder, true, true>(lds, g, S, E); }
                SEAM(pb + 9);
                for (int rep_ = 0; rep_ < (DUP(11) ? 2 : 1); ++rep_) if (EN(11) && IN(pb + 10)) { PHASE_IDS(); float* hbuf = HBUF(); const bf16* Y = WSP(bf16, WS_Y); float* RS = WSP(float, WS_RS); const float* gpost = INP(25) + (size_t)L * DM; const float* gpre = INP(26) + (size_t)L * DM;
                    bf16* H16 = WSP(bf16, WS_H16);
                    { f32x4 gr[16];
_Pragma("unroll") for (int j = 0; j < 16; ++j) gr[j] = ((const f32x4*)gpost)[lane + 64 * j];
 for (int m = gw; m < M; m += NGW) norm_row<false, false, true, true>(H16 + (size_t)m * DM, H16 + (size_t)m * DM, Y + (size_t)m * DM, rep_ ? 0.f : 1.0f, gpost, RS + m, lane, gr); } }
                SEAM(pb + 10);
            } else {
                for (int rep_ = 0; rep_ < (DUP(12) ? 2 : 1); ++rep_) if (EN(12) && IN(pb + 14)) { PHASE_IDS(); pg8::Gemm g{WSP(bf16, WS_H16), WSP(bf16, WS_WPG), M, DM, DM}; pg8::StaticOrder S; S.init(M, DM, G, bid); pg8::EpiPle E{WSP(bf16, WS_Y), WSP(bf16, WS_PPB), DM, WSP(float, WS_RS)};
                    pg8::gemm_phase<pg8::EpiPle, pg8::StaticOrder, true, true>(lds, g, S, E); }
                SEAM(pb + 14);
                for (int rep_ = 0; rep_ < (DUP(13) ? 2 : 1); ++rep_) if (EN(13) && IN(pb + 15)) { PHASE_IDS(); float* hbuf = HBUF(); const bf16* Y = WSP(bf16, WS_Y); float* RS = WSP(float, WS_RS); bf16* H16 = WSP(bf16, WS_H16); const float* gpost = INP(34) + (size_t)L * DM;
                    if (L + 1 < DEPTH) { const float* gpre = INP(3) + (size_t)(L + 1) * DM;
                        { f32x4 gr[16];
_Pragma("unroll") for (int j = 0; j < 16; ++j) gr[j] = ((const f32x4*)gpost)[lane + 64 * j];
 for (int m = gw; m < M; m += NGW) norm_row<false, false, true, true>(H16 + (size_t)m * DM, H16 + (size_t)m * DM, Y + (size_t)m * DM, rep_ ? 0.f : 1.0f, gpost, RS + m, lane, gr); } }
                    else { { f32x4 gr[16];
_Pragma("unroll") for (int j = 0; j < 16; ++j) gr[j] = ((const f32x4*)gpost)[lane + 64 * j];
 for (int m = gw; m < M; m += NGW) norm_row<false, true, false, true>(H16 + (size_t)m * DM, hbuf + (size_t)m * DM, Y + (size_t)m * DM, rep_ ? 0.f : 1.0f, gpost, nullptr, lane, gr); } } }
            }
        }
    }
#undef IN
#undef SEAM
}

extern "C" void kernel_launch(void* const* d_in, const int* in_sizes, int n_in, void* d_out, int out_size, void* d_ws, size_t ws_size, hipStream_t stream) {
    static int grid = 0;
    if (grid == 0) {
        if (n_in != 35 || out_size != M * DM || ws_size < WS_END) { fprintf(stderr, "kernel_launch: unexpected shapes (n_in %d, out %d, ws %zu < %zu)\n", n_in, out_size, ws_size, (size_t)WS_END); grid = -1; return; }
        int dev = 0, cus = 0, per_cu = 0;
        if (hipGetDevice(&dev) != hipSuccess || hipDeviceGetAttribute(&cus, hipDeviceAttributeMultiprocessorCount, dev) != hipSuccess) { grid = -1; return; }
        if (hipFuncSetAttribute((const void*)fwd_kernel, hipFuncAttributeMaxDynamicSharedMemorySize, LDS_BYTES) != hipSuccess) { fprintf(stderr, "kernel_launch: hipFuncSetAttribute failed\n"); grid = -1; return; }
        if (hipOccupancyMaxActiveBlocksPerMultiprocessor(&per_cu, (const void*)fwd_kernel, NTHR, LDS_BYTES) != hipSuccess || per_cu < 1) fprintf(stderr, "kernel_launch: occupancy query says %d\n", per_cu);
        (void)hipGetLastError();
        grid = cus;
    }
    if (grid < 0) return;
    (void)hipMemsetAsync((char*)d_ws + WS_CTL, 0, CTL_ZERO_BYTES, stream);
    Args a; memset(&a, 0, sizeof(a));
    for (int i = 0; i < 35; ++i) a.in[i] = d_in[i];
    a.out = (float*)d_out; a.ws = (unsigned char*)d_ws;
#if MK_SPLIT
    for (int ph = 0; ph < NPHASES; ++ph) { a.ph_lo = ph; a.ph_hi = ph + 1; hipLaunchKernelGGL(fwd_kernel, dim3(grid), dim3(NTHR), LDS_BYTES, stream, a); }
#else
    a.ph_lo = 0; a.ph_hi = NPHASES; hipLaunchKernelGGL(fwd_kernel, dim3(grid), dim3(NTHR), LDS_BYTES, stream, a);
#endif
}
```
